# Optimizing an MI355X kernel written in HIP

```python
import math
import jax
import jax.numpy as jnp
from jax import lax
import numpy as np

D_MODEL = 1024
BATCH = 2
SEQ = 8192
DEPTH = 4

CTX_LEN = 256
GRID_W = 64
EPS = 1e-6
ROPE_BASE = 10000.0
Q_BLOCK = 128
N_MOD = 6
F32 = jnp.float32

GROUP_WIDTH = D_MODEL // 4
MIX_WIDTH = 4 * GROUP_WIDTH

MLA_V = 64
MLA_HEADS = GROUP_WIDTH // MLA_V
MLA_NOPE = 64
MLA_ROPE = 32
MLA_QK = MLA_NOPE + MLA_ROPE
MLA_KV_RANK = 128

SSD_HEAD_DIM = 64
SSD_INNER = GROUP_WIDTH
SSD_HEADS = SSD_INNER // SSD_HEAD_DIM
SSD_GROUPS = 2
SSD_STATE = 64
SSD_CONV = 3
SSD_CHUNK = 128
SSD_GN = SSD_GROUPS * SSD_STATE
SSD_XBC = SSD_INNER + 2 * SSD_GN

S5_WIDTH = GROUP_WIDTH
S5_GROUP = 16
S5_GROUPS = S5_WIDTH // S5_GROUP
S5_STATE = 64

DIFF_V = 64
DIFF_HEADS = GROUP_WIDTH // DIFF_V
DIFF_HEAD = DIFF_V // 2

MLA_COLS = MLA_HEADS * MLA_QK + MLA_KV_RANK + MLA_ROPE
SSD_COLS = SSD_INNER + SSD_XBC + 2 * SSD_HEADS
S5_COLS = S5_WIDTH
DIFF_COLS = 2 * DIFF_HEADS * 2 * DIFF_HEAD + DIFF_HEADS * DIFF_V
IN_COLS = MLA_COLS + SSD_COLS + S5_COLS + DIFF_COLS

MOE_GROUPS = 4
MOE_PER_GROUP = 8
N_EXPERTS = MOE_GROUPS * MOE_PER_GROUP
MOE_TOP_K = 2
EXPERT_HIDDEN = D_MODEL // 4

kernel_name = 'hybrid_mla_ssd_s5_diffattn_hmoe_dit'


def rmsnorm(x, g):
    xf = x.astype(F32)
    y = xf * lax.rsqrt(jnp.mean(xf * xf, axis=-1, keepdims=True) + EPS)
    return (y * g.astype(F32)).astype(x.dtype)


def modulate(x, g, shift, scale):
    return rmsnorm(x, g) * (1.0 + scale) + shift


def _angles(pos, dim):
    inv = ROPE_BASE ** (-jnp.arange(0, dim, 2, dtype=F32) / dim)
    return pos.astype(F32)[:, None] * inv[None, :]


def _rotate_half(x, ang):
    m = ang.shape[-1]
    cos = jnp.cos(ang)[None, :, None, :].astype(x.dtype)
    sin = jnp.sin(ang)[None, :, None, :].astype(x.dtype)
    x1, x2 = x[..., :m], x[..., m:]
    return jnp.concatenate([x1 * cos - x2 * sin, x1 * sin + x2 * cos], axis=-1)


def axial_rope(x, rows, cols):
    half = x.shape[-1] // 2
    return jnp.concatenate([_rotate_half(x[..., :half], _angles(rows, half)),
                            _rotate_half(x[..., half:], _angles(cols, half))], axis=-1)


def blocked_attention(q, k, v, scale):
    b, lq, h, dk = q.shape
    nb = lq // Q_BLOCK
    qb = q.reshape(b, nb, Q_BLOCK, h, dk).transpose(1, 0, 2, 3, 4)

    def one(qblk):
        s = jnp.einsum('bqhd,bkhd->bhqk', qblk, k).astype(F32) * scale
        p = jax.nn.softmax(s, axis=-1)
        return jnp.einsum('bhqk,bkhd->bqhd', p.astype(v.dtype), v)

    o = lax.map(one, qb)
    return o.transpose(1, 0, 2, 3, 4).reshape(b, lq, h, v.shape[-1])


def blocked_diff_attention(q1, q2, k1, k2, v, lam, scale):
    b, lq, h, dk = q1.shape
    nb = lq // Q_BLOCK
    to_blocks = lambda t: t.reshape(b, nb, Q_BLOCK, h, dk).transpose(1, 0, 2, 3, 4)

    def one(qs):
        a1, a2 = qs
        p1 = jax.nn.softmax(jnp.einsum('bqhd,bkhd->bhqk', a1, k1).astype(F32) * scale, axis=-1)
        p2 = jax.nn.softmax(jnp.einsum('bqhd,bkhd->bhqk', a2, k2).astype(F32) * scale, axis=-1)
        return jnp.einsum('bhqk,bkhd->bqhd', (p1 - lam * p2).astype(v.dtype), v)

    o = lax.map(one, (to_blocks(q1), to_blocks(q2)))
    return o.transpose(1, 0, 2, 3, 4).reshape(b, lq, h, v.shape[-1])


def centred_depthwise_conv(x, w, b):
    k = w.shape[0]
    y = lax.conv_general_dilated(x, w[:, None, :].astype(x.dtype), window_strides=(1,),
                                 padding=[(k // 2, k - 1 - k // 2)],
                                 dimension_numbers=('NWC', 'WIO', 'NWC'),
                                 feature_group_count=x.shape[-1])
    return y + b


def split_groups(p):
    o = 0
    parts = []
    for n in (MLA_COLS, SSD_COLS, S5_COLS, DIFF_COLS):
        parts.append(p[..., o:o + n])
        o += n
    return parts


def mla_mixer(p_c, p_l, rows, cols, kv_norm, w_uk, w_uv, q_norm, k_norm, need_ctx):
    nq = MLA_HEADS * MLA_QK

    def project(p):
        b, l, _ = p.shape
        q = rmsnorm(p[..., :nq].reshape(b, l, MLA_HEADS, MLA_QK), q_norm)
        ckv = rmsnorm(p[..., nq:nq + MLA_KV_RANK], kv_norm)
        k_rope = jnp.broadcast_to(p[..., nq + MLA_KV_RANK:][:, :, None, :], (b, l, MLA_HEADS, MLA_ROPE))
        k_nope = (ckv @ w_uk).reshape(b, l, MLA_HEADS, MLA_NOPE)
        v = (ckv @ w_uv).reshape(b, l, MLA_HEADS, MLA_V)
        k = rmsnorm(jnp.concatenate([k_nope, k_rope], axis=-1), k_norm)
        return q, k, v

    def rope_tail(t):
        return jnp.concatenate([t[..., :MLA_NOPE], axial_rope(t[..., MLA_NOPE:], rows, cols)], axis=-1)

    qc, kc, vc = project(p_c)
    ql, kl, vl = project(p_l)
    ql, kl = rope_tail(ql), rope_tail(kl)
    scale = MLA_QK ** -0.5
    b, l = p_l.shape[:2]
    o_l = blocked_attention(ql, jnp.concatenate([kc, kl], 1), jnp.concatenate([vc, vl], 1), scale)
    o_l = o_l.reshape(b, l, MLA_HEADS * MLA_V)
    o_c = None
    if need_ctx:
        o_c = blocked_attention(qc, kc, vc, scale).reshape(b, p_c.shape[1], MLA_HEADS * MLA_V)
    return o_c, o_l


def ssd_scan(x, dt, a, bm, cm, h0):
    b, l, h, p = x.shape
    n = bm.shape[-1]
    nc = l // SSD_CHUNK
    xs = (x * dt[..., None]).reshape(b, nc, SSD_CHUNK, h, p)
    bc = bm.reshape(b, nc, SSD_CHUNK, h, n)
    cc = cm.reshape(b, nc, SSD_CHUNK, h, n)
    a_cum = jnp.cumsum((dt * a).reshape(b, nc, SSD_CHUNK, h), axis=2)
    mask = jnp.tril(jnp.ones((SSD_CHUNK, SSD_CHUNK), dtype=bool))[None, None, :, :, None]
    seg = a_cum[:, :, :, None, :] - a_cum[:, :, None, :, :]
    decay = jnp.exp(jnp.where(mask, seg, -jnp.inf))
    scores = jnp.einsum('bcihn,bcjhn->bcijh', cc, bc) * decay
    y_diag = jnp.einsum('bcijh,bcjhp->bcihp', scores, xs)
    decay_to_end = jnp.exp(a_cum[:, :, -1:, :] - a_cum)
    states = jnp.einsum('bclhn,bclhp->bchpn', bc * decay_to_end[..., None], xs)
    chunk_decay = jnp.exp(a_cum[:, :, -1, :])

    def step(hs, inp):
        dec, st = inp
        return hs * dec[:, :, None, None] + st, hs

    h_final, h_prev = lax.scan(step, h0.astype(F32),
                               (chunk_decay.transpose(1, 0, 2), states.transpose(1, 0, 2, 3, 4)))
    h_prev = h_prev.transpose(1, 0, 2, 3, 4)
    y_off = jnp.einsum('bclhn,bchpn->bclhp', cc * jnp.exp(a_cum)[..., None], h_prev)
    return (y_diag + y_off).reshape(b, l, h, p), h_final


def _ssd_prep(p, conv_w, conv_b, dt_bias):
    b, l, _ = p.shape
    z = p[..., :SSD_INNER]
    xbc = jax.nn.silu(centred_depthwise_conv(p[..., SSD_INNER:SSD_INNER + SSD_XBC], conv_w, conv_b))
    xs = xbc[..., :SSD_INNER].reshape(b, l, SSD_HEADS, SSD_HEAD_DIM)
    rep = SSD_HEADS // SSD_GROUPS
    bm = jnp.repeat(xbc[..., SSD_INNER:SSD_INNER + SSD_GN].reshape(b, l, SSD_GROUPS, SSD_STATE), rep, axis=2)
    cm = jnp.repeat(xbc[..., SSD_INNER + SSD_GN:].reshape(b, l, SSD_GROUPS, SSD_STATE), rep, axis=2)
    dt = jax.nn.softplus(p[..., SSD_INNER + SSD_XBC:].astype(F32).reshape(b, l, 2, SSD_HEADS)
                         + dt_bias.astype(F32))
    return z, xs, bm, cm, dt


def _ssd_out(y, xs, z, d_skip, norm_g):
    b, l = z.shape[:2]
    y = y + xs * d_skip[:, None]
    y = y.reshape(b, l, SSD_INNER) * jax.nn.silu(z)
    return rmsnorm(y, norm_g).astype(z.dtype)


def ssd_mixer(p_c, p_l, conv_w, conv_b, a_log, dt_bias, d_skip, norm_g, need_ctx):
    zc, xc, bc, cc, dtc = _ssd_prep(p_c, conv_w, conv_b, dt_bias)
    zl, xl, bl, cl, dtl = _ssd_prep(p_l, conv_w, conv_b, dt_bias)
    a = -jnp.exp(a_log.astype(F32))
    flip = lambda t: jnp.flip(t, axis=1)
    h0 = jnp.zeros((p_l.shape[0], SSD_HEADS, SSD_HEAD_DIM, SSD_STATE), F32)
    yc_f, hc_f = ssd_scan(xc, dtc[:, :, 0], a[0], bc, cc, h0)
    yl_f, _ = ssd_scan(xl, dtl[:, :, 0], a[0], bl, cl, hc_f)
    yc_b, hc_b = ssd_scan(flip(xc), flip(dtc[:, :, 1]), a[1], flip(bc), flip(cc), h0)
    yl_b, _ = ssd_scan(flip(xl), flip(dtl[:, :, 1]), a[1], flip(bl), flip(cl), hc_b)
    o_l = _ssd_out(yl_f + flip(yl_b), xl, zl, d_skip, norm_g)
    o_c = _ssd_out(yc_f + flip(yc_b), xc, zc, d_skip, norm_g) if need_ctx else None
    return o_c, o_l


def s5_discretise(lam_re, lam_im, log_step, b_re, b_im):
    step = jnp.exp(log_step)[:, None]
    er = jnp.exp(lam_re * step)
    ar = er * jnp.cos(lam_im * step)
    ai = er * jnp.sin(lam_im * step)
    nr, ni = ar - 1.0, ai
    den = lam_re * lam_re + lam_im * lam_im
    fr = (nr * lam_re + ni * lam_im) / den
    fi = (ni * lam_re - nr * lam_im) / den
    br = fr[..., None] * b_re - fi[..., None] * b_im
    bi = fr[..., None] * b_im + fi[..., None] * b_re
    return ar, ai, br, bi


def s5_scan(u, ar, ai, br, bi, s0_re, s0_im):
    l = u.shape[0]
    bu_re = jnp.einsum('gpj,lbgj->lbgp', br, u)
    bu_im = jnp.einsum('gpj,lbgj->lbgp', bi, u)
    bu_re = bu_re.at[0].add(ar * s0_re - ai * s0_im)
    bu_im = bu_im.at[0].add(ar * s0_im + ai * s0_re)
    a_re = jnp.broadcast_to(ar[None, None], (l, 1) + ar.shape)
    a_im = jnp.broadcast_to(ai[None, None], (l, 1) + ai.shape)

    def combine(e1, e2):
        a1r, a1i, b1r, b1i = e1
        a2r, a2i, b2r, b2i = e2
        return (a2r * a1r - a2i * a1i, a2r * a1i + a2i * a1r,
                a2r * b1r - a2i * b1i + b2r, a2r * b1i + a2i * b1r + b2i)

    _, _, s_re, s_im = lax.associative_scan(combine, (a_re, a_im, bu_re, bu_im), axis=0)
    return s_re, s_im


def s5_readout(s_re, s_im, c_re, c_im):
    return jnp.einsum('gjp,lbgp->lbgj', c_re, s_re) - jnp.einsum('gjp,lbgp->lbgj', c_im, s_im)


def s5_mixer(u_c, u_l, lam_re, lam_im, log_step, b_re, b_im, c_re, c_im, d_skip, w_glu, b_glu, need_ctx):
    lam_re, lam_im, log_step = lam_re.astype(F32), lam_im.astype(F32), log_step.astype(F32)
    b_re, b_im, c_re, c_im = b_re.astype(F32), b_im.astype(F32), c_re.astype(F32), c_im.astype(F32)

    def to_lbgj(u):
        b, l, _ = u.shape
        return u.astype(F32).reshape(b, l, S5_GROUPS, S5_GROUP).transpose(1, 0, 2, 3)

    uc, ul = to_lbgj(u_c), to_lbgj(u_l)
    zero = jnp.zeros((u_l.shape[0], S5_GROUPS, S5_STATE), F32)
    yc = jnp.zeros_like(uc)
    yl = jnp.zeros_like(ul)
    for d in range(2):
        rev = (lambda t: t[::-1]) if d == 1 else (lambda t: t)
        ar, ai, br, bi = s5_discretise(lam_re[d], lam_im[d], log_step[d], b_re, b_im)
        sc_re, sc_im = s5_scan(rev(uc), ar, ai, br, bi, zero, zero)
        sl_re, sl_im = s5_scan(rev(ul), ar, ai, br, bi, sc_re[-1], sc_im[-1])
        yl = yl + rev(s5_readout(sl_re, sl_im, c_re[d], c_im[d]))
        if need_ctx:
            yc = yc + rev(s5_readout(sc_re, sc_im, c_re[d], c_im[d]))

    def finish(y, u_in):
        b, l, _ = u_in.shape
        y = y.transpose(1, 0, 2, 3).reshape(b, l, S5_WIDTH) + d_skip * u_in.astype(F32)
        g = jax.nn.gelu(y)
        return (g * jax.nn.sigmoid(g @ w_glu + b_glu)).astype(u_in.dtype)

    o_l = finish(yl, u_l)
    o_c = finish(yc, u_c) if need_ctx else None
    return o_c, o_l


def diff_mixer(p_c, p_l, rows, cols, q_norm, k_norm, lq1, lk1, lq2, lk2, subln, lam_init, need_ctx):
    nq = DIFF_HEADS * 2 * DIFF_HEAD

    def project(p):
        b, l, _ = p.shape
        q = rmsnorm(p[..., :nq].reshape(b, l, 2 * DIFF_HEADS, DIFF_HEAD), q_norm)
        k = rmsnorm(p[..., nq:2 * nq].reshape(b, l, 2 * DIFF_HEADS, DIFF_HEAD), k_norm)
        v = p[..., 2 * nq:].reshape(b, l, DIFF_HEADS, DIFF_V)
        return q, k, v

    def pair(t):
        b, l = t.shape[:2]
        t = t.reshape(b, l, DIFF_HEADS, 2, DIFF_HEAD)
        return t[:, :, :, 0], t[:, :, :, 1]

    qc, kc, vc = project(p_c)
    ql, kl, vl = project(p_l)
    ql, kl = axial_rope(ql, rows, cols), axial_rope(kl, rows, cols)
    lam = (jnp.exp(jnp.sum(lq1.astype(F32) * lk1.astype(F32)))
           - jnp.exp(jnp.sum(lq2.astype(F32) * lk2.astype(F32))) + lam_init)
    scale = DIFF_HEAD ** -0.5

    def attend(q, k, v):
        q1, q2 = pair(q)
        k1, k2 = pair(k)
        o = blocked_diff_attention(q1, q2, k1, k2, v, lam, scale)
        b, l = o.shape[:2]
        return (rmsnorm(o, subln) * (1.0 - lam_init)).reshape(b, l, DIFF_HEADS * DIFF_V)

    o_l = attend(ql, jnp.concatenate([kc, kl], 1), jnp.concatenate([vc, vl], 1))
    o_c = attend(qc, kc, vc) if need_ctx else None
    return o_c, o_l


def hier_moe(h, w_group, b_group, w_expert, b_expert, w_gate, w_up, w_down):
    t = h.shape[0]
    lg = (h @ w_group + b_group).astype(F32)
    g_idx = jnp.argmax(lg, axis=-1)
    g_hot = jax.nn.one_hot(g_idx, MOE_GROUPS, dtype=F32)
    p_group = jnp.sum(jax.nn.softmax(lg, axis=-1) * g_hot, axis=-1, keepdims=True)
    le = (jnp.einsum('td,gde->tge', h, w_expert) + b_expert).astype(F32)
    le = jnp.einsum('tg,tge->te', g_hot, le)
    top_v, top_i = lax.top_k(le, MOE_TOP_K)
    w_top = jax.nn.softmax(top_v, axis=-1) * p_group
    inner = jnp.einsum('tk,tke->te', w_top, jax.nn.one_hot(top_i, MOE_PER_GROUP, dtype=F32))
    gates = (g_hot[:, :, None] * inner[:, None, :]).reshape(t, N_EXPERTS).astype(h.dtype)
    out = jnp.zeros_like(h)
    for e in range(N_EXPERTS):
        hid = jax.nn.silu(h @ w_gate[e]) * (h @ w_up[e])
        out = out + gates[:, e:e + 1] * (hid @ w_down[e])
    return out


def setup_inputs(seed: int = 0) -> dict:
    key = jax.random.key(seed)
    keys = list(jax.random.split(key, 64))
    nk = lambda: keys.pop()
    nrm = lambda shape, s: jax.random.normal(nk(), shape, F32) * s
    gain = lambda shape: 1.0 + 0.05 * jax.random.normal(nk(), shape, F32)
    unif = lambda shape, lo, hi: jax.random.uniform(nk(), shape, F32, lo, hi)
    dm = D_MODEL
    inp = {}
    inp['x'] = nrm((BATCH, SEQ, dm), 1.0)
    inp['c'] = nrm((BATCH, dm), 1.0)
    inp['ctx'] = nrm((BATCH, CTX_LEN, dm), 1.0)
    inp['c_ctx'] = nrm((dm,), 1.0)
    inp['w_ada'] = nrm((DEPTH, dm, N_MOD * dm), 0.5 * dm ** -0.5)
    inp['b_ada'] = nrm((DEPTH, N_MOD * dm), 0.02)
    inp['norm1'] = gain((DEPTH, dm))
    inp['norm2'] = gain((DEPTH, dm))
    inp['w_in'] = nrm((DEPTH, dm, IN_COLS), dm ** -0.5)
    inp['w_out'] = nrm((DEPTH, MIX_WIDTH, dm), MIX_WIDTH ** -0.5)
    inp['mla_kv_norm'] = gain((DEPTH, MLA_KV_RANK))
    inp['mla_w_uk'] = nrm((DEPTH, MLA_KV_RANK, MLA_HEADS * MLA_NOPE), MLA_KV_RANK ** -0.5)
    inp['mla_w_uv'] = nrm((DEPTH, MLA_KV_RANK, MLA_HEADS * MLA_V), MLA_KV_RANK ** -0.5)
    inp['mla_q_norm'] = gain((DEPTH, MLA_QK))
    inp['mla_k_norm'] = gain((DEPTH, MLA_QK))
    inp['ssd_conv_w'] = nrm((DEPTH, SSD_CONV, SSD_XBC), SSD_CONV ** -0.5)
    inp['ssd_conv_b'] = nrm((DEPTH, SSD_XBC), 0.02)
    inp['ssd_a_log'] = jnp.log(unif((DEPTH, 2, SSD_HEADS), 1.0, 16.0))
    dt0 = jnp.exp(unif((DEPTH, 2, SSD_HEADS), math.log(1e-3), math.log(1e-1)))
    inp['ssd_dt_bias'] = dt0 + jnp.log(-jnp.expm1(-dt0))
    inp['ssd_d'] = gain((DEPTH, SSD_HEADS))
    inp['ssd_norm'] = gain((DEPTH, SSD_INNER))
    n_idx = jnp.arange(S5_STATE, dtype=F32)
    inp['s5_lam_re'] = -0.5 + 0.01 * jax.random.normal(nk(), (DEPTH, 2, S5_GROUPS, S5_STATE), F32)
    inp['s5_lam_im'] = math.pi * n_idx + 0.01 * jax.random.normal(nk(), (DEPTH, 2, S5_GROUPS, S5_STATE), F32)
    inp['s5_log_step'] = unif((DEPTH, 2, S5_GROUPS), math.log(1e-3), math.log(1e-1))
    inp['s5_b_re'] = nrm((DEPTH, S5_GROUPS, S5_STATE, S5_GROUP), (2 * S5_GROUP) ** -0.5)
    inp['s5_b_im'] = nrm((DEPTH, S5_GROUPS, S5_STATE, S5_GROUP), (2 * S5_GROUP) ** -0.5)
    inp['s5_c_re'] = nrm((DEPTH, 2, S5_GROUPS, S5_GROUP, S5_STATE), S5_STATE ** -0.5)
    inp['s5_c_im'] = nrm((DEPTH, 2, S5_GROUPS, S5_GROUP, S5_STATE), S5_STATE ** -0.5)
    inp['s5_d'] = nrm((DEPTH, S5_WIDTH), 1.0)
    inp['s5_w_glu'] = nrm((DEPTH, S5_WIDTH, S5_WIDTH), S5_WIDTH ** -0.5)
    inp['s5_b_glu'] = nrm((DEPTH, S5_WIDTH), 0.02)
    inp['diff_q_norm'] = gain((DEPTH, DIFF_HEAD))
    inp['diff_k_norm'] = gain((DEPTH, DIFF_HEAD))
    inp['diff_lq1'] = nrm((DEPTH, DIFF_HEAD), 0.1)
    inp['diff_lk1'] = nrm((DEPTH, DIFF_HEAD), 0.1)
    inp['diff_lq2'] = nrm((DEPTH, DIFF_HEAD), 0.1)
    inp['diff_lk2'] = nrm((DEPTH, DIFF_HEAD), 0.1)
    inp['diff_subln'] = gain((DEPTH, DIFF_V))
    inp['moe_w_group'] = nrm((DEPTH, dm, MOE_GROUPS), dm ** -0.5)
    inp['moe_b_group'] = nrm((DEPTH, MOE_GROUPS), 0.01)
    inp['moe_w_expert'] = nrm((DEPTH, MOE_GROUPS, dm, MOE_PER_GROUP), dm ** -0.5)
    inp['moe_b_expert'] = nrm((DEPTH, MOE_GROUPS, MOE_PER_GROUP), 0.01)
    inp['moe_w_gate'] = nrm((DEPTH, N_EXPERTS, dm, EXPERT_HIDDEN), dm ** -0.5)
    inp['moe_w_up'] = nrm((DEPTH, N_EXPERTS, dm, EXPERT_HIDDEN), dm ** -0.5)
    inp['moe_w_down'] = nrm((DEPTH, N_EXPERTS, EXPERT_HIDDEN, dm), EXPERT_HIDDEN ** -0.5)
    return inp


def reference(x, c, ctx, c_ctx, w_ada, b_ada, norm1, norm2, w_in, w_out,
              mla_kv_norm, mla_w_uk, mla_w_uv, mla_q_norm, mla_k_norm,
              ssd_conv_w, ssd_conv_b, ssd_a_log, ssd_dt_bias, ssd_d, ssd_norm,
              s5_lam_re, s5_lam_im, s5_log_step, s5_b_re, s5_b_im, s5_c_re, s5_c_im,
              s5_d, s5_w_glu, s5_b_glu,
              diff_q_norm, diff_k_norm, diff_lq1, diff_lk1, diff_lq2, diff_lk2, diff_subln,
              moe_w_group, moe_b_group, moe_w_expert, moe_b_expert, moe_w_gate, moe_w_up, moe_w_down):
    bsz, seq, d = x.shape
    n_rows = seq // GRID_W
    rows = jnp.repeat(jnp.arange(n_rows, dtype=jnp.int32), GRID_W, total_repeat_length=seq)
    cols = jnp.broadcast_to(jnp.arange(GRID_W, dtype=jnp.int32)[None, :], (n_rows, GRID_W)).reshape(seq)
    x_lat, x_ctx = x, ctx
    for i in range(DEPTH):
        need_ctx = i < DEPTH - 1
        mod_l = (jax.nn.silu(c) @ w_ada[i] + b_ada[i]).reshape(bsz, N_MOD, 1, d)
        mod_c = (jax.nn.silu(c_ctx) @ w_ada[i] + b_ada[i]).reshape(N_MOD, d)
        p_l = modulate(x_lat, norm1[i], mod_l[:, 0], mod_l[:, 1]) @ w_in[i]
        p_c = modulate(x_ctx, norm1[i], mod_c[0], mod_c[1]) @ w_in[i]
        mla_l, ssd_l, s5_l, diff_l = split_groups(p_l)
        mla_c, ssd_c, s5_c, diff_c = split_groups(p_c)
        a_c, a_l = mla_mixer(mla_c, mla_l, rows, cols, mla_kv_norm[i], mla_w_uk[i], mla_w_uv[i],
                             mla_q_norm[i], mla_k_norm[i], need_ctx)
        b_c, b_l = ssd_mixer(ssd_c, ssd_l, ssd_conv_w[i], ssd_conv_b[i], ssd_a_log[i], ssd_dt_bias[i],
                             ssd_d[i], ssd_norm[i], need_ctx)
        s_c, s_l = s5_mixer(s5_c, s5_l, s5_lam_re[i], s5_lam_im[i], s5_log_step[i], s5_b_re[i], s5_b_im[i],
                            s5_c_re[i], s5_c_im[i], s5_d[i], s5_w_glu[i], s5_b_glu[i], need_ctx)
        lam_init = 0.8 - 0.6 * math.exp(-0.3 * i)
        f_c, f_l = diff_mixer(diff_c, diff_l, rows, cols, diff_q_norm[i], diff_k_norm[i], diff_lq1[i],
                              diff_lk1[i], diff_lq2[i], diff_lk2[i], diff_subln[i], lam_init, need_ctx)
        x_lat = x_lat + mod_l[:, 2] * (jnp.concatenate([a_l, b_l, s_l, f_l], axis=-1) @ w_out[i])
        h_l = modulate(x_lat, norm2[i], mod_l[:, 3], mod_l[:, 4]).reshape(-1, d)
        moe_p = (moe_w_group[i], moe_b_group[i], moe_w_expert[i], moe_b_expert[i],
                 moe_w_gate[i], moe_w_up[i], moe_w_down[i])
        if need_ctx:
            x_ctx = x_ctx + mod_c[2] * (jnp.concatenate([a_c, b_c, s_c, f_c], axis=-1) @ w_out[i])
            h_c = modulate(x_ctx, norm2[i], mod_c[3], mod_c[4]).reshape(-1, d)
            y = hier_moe(jnp.concatenate([h_l, h_c], axis=0), *moe_p)
            x_ctx = x_ctx + mod_c[5] * y[h_l.shape[0]:].reshape(x_ctx.shape)
            y_l = y[:h_l.shape[0]]
        else:
            y_l = hier_moe(h_l, *moe_p)
        x_lat = x_lat + mod_l[:, 5] * y_l.reshape(x_lat.shape)
    return x_lat
```

```cpp
#include <hip/hip_runtime.h>
#include <cstdio>
#include <cstdint>
#include <cstring>

typedef unsigned short u16;
typedef __attribute__((ext_vector_type(8))) short bf16x8;
typedef __attribute__((ext_vector_type(16))) float f32x16;
typedef __bf16 bf2_t __attribute__((ext_vector_type(2)));
typedef float f2_t __attribute__((ext_vector_type(2)));
#define DI __device__ __forceinline__
#define MFMA32(a, b, c) __builtin_amdgcn_mfma_f32_32x32x16_bf16((a), (b), (c), 0, 0, 0)

constexpr int D = 1024, NB = 2, SEQ = 8192, CTX = 256, LSEQ = CTX + SEQ, T = NB * LSEQ, DEPTH = 4;
constexpr int NTHR = 512, NWAVE = 8;
constexpr int PC = 2432;
constexpr int IN_COLS = 2344;
constexpr int C_MQ = 0, C_MCKV = 384, C_MKR = 512, C_SZ = 544, C_SXBC = 800, C_SDT = 1312, C_S5U = 1320, C_DQ = 1576, C_DK = 1832, C_DV = 2088;
constexpr int NCH = LSEQ / 128;
constexpr float EPS = 1e-6f;
constexpr float LOG2E = 1.4426950408889634f;

constexpr size_t al256(size_t x) { return (x + 255) & ~(size_t)255; }
constexpr size_t WS_CTL = 0;
constexpr size_t CTL_CNT_OFF = 16384;
constexpr size_t CTL_BYTES = 32768;
constexpr size_t WS_MODS = WS_CTL + CTL_BYTES;
constexpr size_t WS_S5A = al256(WS_MODS + (size_t)DEPTH * 3 * 6144 * 4);
constexpr size_t WS_S5BT = al256(WS_S5A + (size_t)DEPTH * 2 * 16 * 64 * 2 * 4);
constexpr size_t WS_S5CT = al256(WS_S5BT + (size_t)DEPTH * 2 * 16 * 128 * 16 * 2);
constexpr size_t WS_X = al256(WS_S5CT + (size_t)DEPTH * 2 * 16 * 16 * 128 * 2);
constexpr size_t WS_HN = al256(WS_X + (size_t)T * D * 4);
constexpr size_t WS_P = al256(WS_HN + (size_t)T * D * 2);
constexpr size_t WS_QM = al256(WS_P + (size_t)T * PC * 2);
constexpr size_t WS_KM = al256(WS_QM + (size_t)NB * 4 * LSEQ * 96 * 2);
constexpr size_t WS_VTM = al256(WS_KM + (size_t)NB * 4 * LSEQ * 96 * 2);
constexpr size_t WS_QD = al256(WS_VTM + (size_t)NB * 4 * 64 * LSEQ * 2);
constexpr size_t WS_KD = al256(WS_QD + (size_t)NB * 4 * LSEQ * 64 * 2);
constexpr size_t WS_VTD = al256(WS_KD + (size_t)NB * 4 * LSEQ * 64 * 2);
constexpr size_t WS_CAT = al256(WS_VTD + (size_t)NB * 4 * 64 * LSEQ * 2);
constexpr size_t WS_SXS = al256(WS_CAT + (size_t)T * D * 2);
constexpr size_t WS_SB = al256(WS_SXS + (size_t)T * 256 * 2);
constexpr size_t WS_SC = al256(WS_SB + (size_t)T * 128 * 2);
constexpr size_t WS_SDT = al256(WS_SC + (size_t)T * 128 * 2);
constexpr size_t WS_SE = al256(WS_SDT + (size_t)T * 8 * 4);
constexpr size_t WS_SST = al256(WS_SE + (size_t)T * 8 * 4);
constexpr size_t WS_SCD = al256(WS_SST + (size_t)NB * 2 * NCH * 4 * 4096 * 4);
constexpr size_t WS_S5F = al256(WS_SCD + (size_t)NB * 2 * NCH * 4 * 4);
constexpr size_t WS_TOKE = al256(WS_S5F + (size_t)NB * 2 * NCH * 16 * 64 * 2 * 4);
constexpr size_t WS_TOKW = al256(WS_TOKE + (size_t)T * 2 * 4);
constexpr size_t WS_LIST = al256(WS_TOKW + (size_t)T * 2 * 4);
constexpr size_t WS_HID = al256(WS_LIST + (size_t)32 * T * 4);
constexpr size_t WS_Y = al256(WS_HID + (size_t)T * 2 * 256 * 2);
constexpr size_t WS_WIN = al256(WS_Y + (size_t)T * 2 * D * 2);
constexpr size_t WS_WOUT = al256(WS_WIN + (size_t)PC * D * 2);
constexpr size_t WS_WGU = al256(WS_WOUT + (size_t)D * D * 2);
constexpr size_t WS_WD = al256(WS_WGU + (size_t)32 * 512 * D * 2);
constexpr size_t WS_WGLU = al256(WS_WD + (size_t)32 * D * 256 * 2);
constexpr size_t WS_WKV = al256(WS_WGLU + (size_t)256 * 256 * 2);
constexpr size_t WS_END = al256(WS_WKV + (size_t)512 * 128 * 2);

constexpr int LDS_BYTES = 150 * 1024;

struct Params {
    const float* in[45];
    float* out;
    unsigned char* ws;
    int lay_lo, lay_hi, ph_lo, ph_hi;
    int use_bar, pad0;
};
enum { I_X = 0, I_C, I_CTX, I_CCTX, I_WADA, I_BADA, I_NORM1, I_NORM2, I_WIN, I_WOUT, I_MKVN, I_MWUK, I_MWUV, I_MQN, I_MKN,
       I_SCW, I_SCB, I_SALOG, I_SDTB, I_SD, I_SNORM, I_5LRE, I_5LIM, I_5LS, I_5BRE, I_5BIM, I_5CRE, I_5CIM, I_5D, I_5WGLU, I_5BGLU,
       I_DQN, I_DKN, I_DLQ1, I_DLK1, I_DLQ2, I_DLK2, I_DSUB, I_MWG, I_MBG, I_MWE, I_MBE, I_MWGATE, I_MWUP, I_MWDOWN };

DI int opq_tid() { int t = threadIdx.x; asm volatile("" : "+v"(t)); return t; }
DI float bf2f(u16 v) { return __uint_as_float(((unsigned)v) << 16); }
DI unsigned pack_bf2(float a, float b) { f2_t f = {a, b}; bf2_t r = __builtin_convertvector(f, bf2_t); return __builtin_bit_cast(unsigned, r); }
DI u16 f2bf(float a) { return (u16)(pack_bf2(a, 0.f) & 0xffffu); }
DI float bflo(unsigned w) { return __uint_as_float(w << 16); }
DI float bfhi(unsigned w) { return __uint_as_float(w & 0xffff0000u); }
DI int crow(int reg, int h) { return (reg & 3) + 8 * (reg >> 2) + 4 * h; }
DI int kpos(int t) { return (t & ~12) | ((t & 4) << 1) | ((t & 8) >> 1); }
DI float wave_sum(float v) {
#pragma unroll
    for (int o = 32; o >= 1; o >>= 1) v += __shfl_xor(v, o, 64);
    return v;
}
DI float silu_f(float x) { return x / (1.f + __expf(-x)); }
DI f32x16 zero16() { f32x16 z;
#pragma unroll
    for (int i = 0; i < 16; ++i) z[i] = 0.f; return z; }
DI bf16x8 ld_frag(const unsigned char* p) { return *(const bf16x8*)p; }
DI int chunk_at(int dir, int k) { return dir == 0 ? k : (k < 2 ? 1 - k : (NCH + 1) - k); }

#define XB_TMO      128
#define XB_XCNT(j)  (256  + 64 * (j))
#define XB_XSUB(j)  (1280 + 64 * (j))
#define XB_XGEN(j)  (2304 + 64 * (j))
#define XB_TOP      3328
#define XB_TOPGEN   3392
#define XCD_BAR_WORDS 3456
#define XB_SPIN_CAP (1u << 20)
#define LAS __attribute__((address_space(3)))

DI unsigned xb_ld(unsigned* p)              { return __hip_atomic_load(p, __ATOMIC_RELAXED, __HIP_MEMORY_SCOPE_AGENT); }
DI unsigned xb_add(unsigned* p, unsigned v) { return __hip_atomic_fetch_add(p, v, __ATOMIC_RELAXED, __HIP_MEMORY_SCOPE_AGENT); }
DI unsigned xb_xcc_id() { return (unsigned)__builtin_amdgcn_s_getreg((3 << 11) | 20) & 0xFu; }
#define XB_SPIN(cond, bar) do { unsigned _sp = 0; while (cond) { __builtin_amdgcn_s_sleep(1); \
    if ((++_sp & 255u) == 0u) { if (xb_ld(&(bar)[XB_TMO])) break; if (_sp > XB_SPIN_CAP) { atomicAdd(&(bar)[XB_TMO], 1u); break; } } } } while (0)

struct XcdBarrier { unsigned* bar; unsigned x; volatile LAS unsigned* st; };

DI XcdBarrier xcd_barrier_post(unsigned* bar, volatile LAS unsigned* st) {
    XcdBarrier b; b.bar = bar; b.x = xb_xcc_id(); b.st = st;
    if (threadIdx.x == 0) (void)xb_add(&bar[XB_XCNT(b.x)], 1u);
    return b;
}
DI void xcd_barrier_complete(unsigned* bar, unsigned x, unsigned& nloc, unsigned& nx) {
    const unsigned G = gridDim.x * gridDim.y * gridDim.z;
    unsigned sum, cnt, mine, sp = 0u;
    for (;;) {
        sum = 0u; cnt = 0u; mine = 0u;
#pragma unroll
        for (unsigned j = 0; j < 16; ++j) { const unsigned c = xb_ld(&bar[XB_XCNT(j)]); sum += c; cnt += (c > 0u) ? 1u : 0u; mine = (j == x) ? c : mine; }
        if (sum == G) break;
        __builtin_amdgcn_s_sleep(1);
        if ((++sp & 255u) == 0u) { if (xb_ld(&bar[XB_TMO])) break; if (sp > XB_SPIN_CAP) { atomicAdd(&bar[XB_TMO], 1u); break; } }
    }
    nloc = mine > 0u ? mine : 1u; nx = cnt > 0u ? cnt : 1u;
}
DI void xcd_barrier(const XcdBarrier& b) {
    asm volatile("s_waitcnt vmcnt(0)" ::: "memory");
    __syncthreads();
    if (threadIdx.x == 0) {
        unsigned* bar = b.bar;
        __builtin_amdgcn_s_waitcnt(0);
        unsigned nloc = b.st[0], nx = b.st[1];
        if (nloc == 0u) { xcd_barrier_complete(bar, b.x, nloc, nx); b.st[0] = nloc; b.st[1] = nx; }
        const unsigned old = xb_add(&bar[XB_XSUB(b.x)], 1u);
        const unsigned gen = old / nloc;
        if (old + 1u == (gen + 1u) * nloc) {
            __builtin_amdgcn_fence(__ATOMIC_RELEASE, "agent");
            asm volatile("s_waitcnt vmcnt(0)" ::: "memory");
            const unsigned og = xb_add(&bar[XB_TOP], 1u);
            const unsigned tg = og / nx;
            if (og + 1u == (tg + 1u) * nx) xb_add(&bar[XB_TOPGEN], 1u);
            else XB_SPIN(xb_ld(&bar[XB_TOPGEN]) == tg, bar);
            __builtin_amdgcn_fence(__ATOMIC_ACQUIRE, "agent");
            xb_add(&bar[XB_XGEN(b.x)], 1u);
            asm volatile("s_waitcnt vmcnt(0)" ::: "memory");
        } else {
            XB_SPIN(xb_ld(&bar[XB_XGEN(b.x)]) == gen, bar);
            __builtin_amdgcn_fence(__ATOMIC_ACQUIRE, "agent");
            asm volatile("s_waitcnt vmcnt(0)" ::: "memory");
        }
    }
    __syncthreads();
}

constexpr int LDT = 144;
template <int WGM, int WGN, int WM, int WN, class ARow, class Epi>
DI void gemm_tile(unsigned char* smem, ARow arow, const u16* __restrict__ Bt, int ldb, int n0, int K, Epi epi) {
    constexpr int BM = WGM * WM * 32, BN = WGN * WN * 32;
    constexpr int A_BYTES = BM * LDT, B_BYTES = BN * LDT, STAGE = A_BYTES + B_BYTES;
    constexpr int NA = BM * 8 / NTHR, NBc = BN * 8 / NTHR;
    static_assert(2 * STAGE <= LDS_BYTES, "gemm tile LDS");
    const int tid = opq_tid(), lane = tid & 63, wave = tid >> 6;
    const int wr = wave / WGN, wc = wave % WGN;
    const int lr = lane & 31, lh = lane >> 5;
    const uint4* ap[NA]; const uint4* bp[NBc];
#pragma unroll
    for (int i = 0; i < NA; ++i) ap[i] = (const uint4*)arow((tid >> 3) + 64 * i) + (tid & 7);
#pragma unroll
    for (int i = 0; i < NBc; ++i) bp[i] = (const uint4*)(Bt + (size_t)(n0 + (tid >> 3) + 64 * i) * ldb) + (tid & 7);
    const int woff = (tid >> 3) * LDT + (tid & 7) * 16;
    uint4 ra[NA], rb[NBc];
#pragma unroll
    for (int i = 0; i < NA; ++i) ra[i] = ap[i][0];
#pragma unroll
    for (int i = 0; i < NBc; ++i) rb[i] = bp[i][0];
#pragma unroll
    for (int i = 0; i < NA; ++i) *(uint4*)(smem + woff + i * 64 * LDT) = ra[i];
#pragma unroll
    for (int i = 0; i < NBc; ++i) *(uint4*)(smem + A_BYTES + woff + i * 64 * LDT) = rb[i];
    __syncthreads();
    f32x16 acc[WM][WN];
#pragma unroll
    for (int mi = 0; mi < WM; ++mi)
#pragma unroll
        for (int ni = 0; ni < WN; ++ni) acc[mi][ni] = zero16();
    const int nk = K / 64;
    const int a_rd = (wr * WM * 32 + lr) * LDT + lh * 16;
    const int b_rd = A_BYTES + (wc * WN * 32 + lr) * LDT + lh * 16;
    for (int kt = 0; kt < nk; ++kt) {
        const unsigned char* st = smem + (kt & 1) * STAGE;
        if (kt + 1 < nk) {
#pragma unroll
            for (int i = 0; i < NA; ++i) ra[i] = ap[i][(kt + 1) * 8];
#pragma unroll
            for (int i = 0; i < NBc; ++i) rb[i] = bp[i][(kt + 1) * 8];
        }
#pragma unroll
        for (int s = 0; s < 4; ++s) {
            bf16x8 a[WM], b[WN];
#pragma unroll
            for (int mi = 0; mi < WM; ++mi) a[mi] = ld_frag(st + a_rd + mi * 32 * LDT + s * 32);
#pragma unroll
            for (int ni = 0; ni < WN; ++ni) b[ni] = ld_frag(st + b_rd + ni * 32 * LDT + s * 32);
#pragma unroll
            for (int mi = 0; mi < WM; ++mi)
#pragma unroll
                for (int ni = 0; ni < WN; ++ni) acc[mi][ni] = MFMA32(a[mi], b[ni], acc[mi][ni]);
        }
        if (kt + 1 < nk) {
            unsigned char* sn = smem + ((kt + 1) & 1) * STAGE;
#pragma unroll
            for (int i = 0; i < NA; ++i) *(uint4*)(sn + woff + i * 64 * LDT) = ra[i];
#pragma unroll
            for (int i = 0; i < NBc; ++i) *(uint4*)(sn + A_BYTES + woff + i * 64 * LDT) = rb[i];
        }
        __syncthreads();
    }
    epi(acc, wr * WM * 32, wc * WN * 32);
}

DI void ph_prologue(const Params& P, unsigned char* smem) {
    unsigned char* ws = P.ws;
    const int tid = opq_tid();
    const size_t gtid = (size_t)blockIdx.x * NTHR + tid, gstr = (size_t)gridDim.x * NTHR;
    {
        float4* xb = (float4*)(ws + WS_X);
        const float4* xin = (const float4*)P.in[I_X]; const float4* cin = (const float4*)P.in[I_CTX];
        for (size_t i = gtid; i < (size_t)T * 256; i += gstr) {
            const int row = (int)(i >> 8), c4 = (int)(i & 255);
            const int b = row / LSEQ, u = row % LSEQ;
            xb[i] = (u < CTX) ? cin[((size_t)(b * CTX + u)) * 256 + c4] : xin[((size_t)(b * SEQ + u - CTX)) * 256 + c4];
        }
    }
    {
        float* sl = (float*)smem;
        float* red = sl + 3072;
        for (int i = tid; i < 3072; i += NTHR) {
            const int w = i >> 10, k = i & 1023;
            const float v = (w < 2) ? P.in[I_C][w * 1024 + k] : P.in[I_CCTX][k];
            sl[i] = v / (1.f + expf(-v));
        }
        __syncthreads();
        float* mods = (float*)(ws + WS_MODS);
        const int cg = tid & 15, ks = tid >> 4;
        for (int item = blockIdx.x; item < DEPTH * 96; item += gridDim.x) {
            const int l = item / 96, cb = item % 96;
            const float* wp = P.in[I_WADA] + ((size_t)l * 1024 + ks * 32) * 6144 + cb * 64 + cg * 4;
            float acc[3][4];
#pragma unroll
            for (int w = 0; w < 3; ++w)
#pragma unroll
                for (int j = 0; j < 4; ++j) acc[w][j] = 0.f;
#pragma unroll 8
            for (int kk = 0; kk < 32; ++kk) {
                const float4 wv = *(const float4*)(wp + (size_t)kk * 6144);
                const int k = ks * 32 + kk;
#pragma unroll
                for (int w = 0; w < 3; ++w) {
                    const float s = sl[w * 1024 + k];
                    acc[w][0] += s * wv.x; acc[w][1] += s * wv.y; acc[w][2] += s * wv.z; acc[w][3] += s * wv.w;
                }
            }
#pragma unroll
            for (int w = 0; w < 3; ++w)
#pragma unroll
                for (int j = 0; j < 4; ++j) red[(ks * 3 + w) * 64 + cg * 4 + j] = acc[w][j];
            __syncthreads();
            if (tid < 192) {
                const int w = tid >> 6, j = tid & 63;
                float s = P.in[I_BADA][l * 6144 + cb * 64 + j];
                for (int q = 0; q < 32; ++q) s += red[(q * 3 + w) * 64 + j];
                mods[((size_t)l * 3 + w) * 6144 + cb * 64 + j] = s;
            }
            __syncthreads();
        }
    }
    {
        float* s5a = (float*)(ws + WS_S5A); u16* bt = (u16*)(ws + WS_S5BT); u16* ct = (u16*)(ws + WS_S5CT);
        for (size_t idx = gtid; idx < (size_t)DEPTH * 2 * 16 * 64; idx += gstr) {
            const int p = (int)(idx & 63), g = (int)((idx >> 6) & 15), d = (int)((idx >> 10) & 1), l = (int)(idx >> 11);
            const float lr = P.in[I_5LRE][idx], li = P.in[I_5LIM][idx];
            const float step = expf(P.in[I_5LS][(l * 2 + d) * 16 + g]);
            const float er = expf(lr * step);
            const float ar = er * cosf(li * step), ai = er * sinf(li * step);
            const float nr = ar - 1.f, ni = ai, den = lr * lr + li * li;
            const float fr = (nr * lr + ni * li) / den, fi = (ni * lr - nr * li) / den;
            s5a[idx * 2] = ar; s5a[idx * 2 + 1] = ai;
            const size_t ldg = (size_t)(l * 2 + d) * 16 + g;
            const float* bre = P.in[I_5BRE] + (((size_t)l * 16 + g) * 64 + p) * 16;
            const float* bim = P.in[I_5BIM] + (((size_t)l * 16 + g) * 64 + p) * 16;
            for (int j = 0; j < 16; ++j) {
                const float br = fr * bre[j] - fi * bim[j], bi = fr * bim[j] + fi * bre[j];
                bt[(ldg * 128 + p) * 16 + j] = f2bf(br);
                bt[(ldg * 128 + 64 + p) * 16 + j] = f2bf(bi);
            }
            for (int jo = 0; jo < 16; ++jo) {
                const float cre = P.in[I_5CRE][(ldg * 16 + jo) * 64 + p], cim = P.in[I_5CIM][(ldg * 16 + jo) * 64 + p];
                ct[(ldg * 16 + jo) * 128 + 2 * p] = f2bf(cre);
                ct[(ldg * 16 + jo) * 128 + 2 * p + 1] = f2bf(-cim);
            }
        }
    }
}

DI void conv_tile64(float* tile, const float* __restrict__ src, int sstride, int R0, int C0, int Cvalid,
                    u16* __restrict__ dst, int dstride, int drow_base, int drow_hi) {
    const int tid = opq_tid();
#pragma unroll
    for (int it = 0; it < 2; ++it) {
        const int i = (tid >> 4) + 32 * it, j4 = (tid & 15) * 4;
        float4 v = make_float4(0.f, 0.f, 0.f, 0.f);
        if (C0 + j4 < Cvalid) v = *(const float4*)(src + (size_t)(R0 + i) * sstride + C0 + j4);
        float* tp = tile + i * 65 + j4;
        tp[0] = v.x; tp[1] = v.y; tp[2] = v.z; tp[3] = v.w;
    }
    __syncthreads();
    {
        const int j = tid >> 3, i8 = (tid & 7) * 8;
        uint4 o;
        o.x = pack_bf2(tile[(i8 + 0) * 65 + j], tile[(i8 + 1) * 65 + j]);
        o.y = pack_bf2(tile[(i8 + 2) * 65 + j], tile[(i8 + 3) * 65 + j]);
        o.z = pack_bf2(tile[(i8 + 4) * 65 + j], tile[(i8 + 5) * 65 + j]);
        o.w = pack_bf2(tile[(i8 + 6) * 65 + j], tile[(i8 + 7) * 65 + j]);
        const int drow = drow_base + (j >> 5) * drow_hi + (j & 31);
        *(uint4*)(dst + (size_t)drow * dstride + R0 + i8) = o;
    }
    __syncthreads();
}

DI void ph_norm1(const Params& P, int layer, unsigned char* smem) {
    unsigned char* ws = P.ws;
    const int tid = opq_tid(), lane = tid & 63, wave = tid >> 6;
    {
        float* xbuf = (float*)(ws + WS_X); u16* hn = (u16*)(ws + WS_HN); const u16* yb = (const u16*)(ws + WS_Y);
        const float* mods = (const float*)(ws + WS_MODS);
        const float* g1 = P.in[I_NORM1] + layer * 1024;
        float4 gv[4];
#pragma unroll
        for (int i = 0; i < 4; ++i) gv[i] = *(const float4*)(g1 + i * 256 + lane * 4);
        for (int row = blockIdx.x * NWAVE + wave; row < T; row += gridDim.x * NWAVE) {
            const int b = row / LSEQ, u = row % LSEQ, which = (u < CTX) ? 2 : b;
            float* xr = xbuf + (size_t)row * 1024;
            float4 v[4];
#pragma unroll
            for (int i = 0; i < 4; ++i) v[i] = *(const float4*)(xr + i * 256 + lane * 4);
            if (layer > 0) {
                const float* g2 = mods + ((size_t)(layer - 1) * 3 + which) * 6144 + 5 * 1024;
                const u16* y0 = yb + (size_t)(2 * row) * 1024; const u16* y1 = y0 + 1024;
#pragma unroll
                for (int i = 0; i < 4; ++i) {
                    const uint2 a = *(const uint2*)(y0 + i * 256 + lane * 4), c = *(const uint2*)(y1 + i * 256 + lane * 4);
                    const float4 gg = *(const float4*)(g2 + i * 256 + lane * 4);
                    v[i].x += gg.x * (bflo(a.x) + bflo(c.x)); v[i].y += gg.y * (bfhi(a.x) + bfhi(c.x));
                    v[i].z += gg.z * (bflo(a.y) + bflo(c.y)); v[i].w += gg.w * (bfhi(a.y) + bfhi(c.y));
                    *(float4*)(xr + i * 256 + lane * 4) = v[i];
                }
            }
            float ss = 0.f;
#pragma unroll
            for (int i = 0; i < 4; ++i) ss += v[i].x * v[i].x + v[i].y * v[i].y + v[i].z * v[i].z + v[i].w * v[i].w;
            ss = wave_sum(ss);
            const float rstd = rsqrtf(ss * (1.f / 1024.f) + EPS);
            const float* sh = mods + ((size_t)layer * 3 + which) * 6144; const float* sc = sh + 1024;
#pragma unroll
            for (int i = 0; i < 4; ++i) {
                const float4 s4 = *(const float4*)(sh + i * 256 + lane * 4), c4 = *(const float4*)(sc + i * 256 + lane * 4);
                uint2 o;
                o.x = pack_bf2(v[i].x * rstd * gv[i].x * (1.f + c4.x) + s4.x, v[i].y * rstd * gv[i].y * (1.f + c4.y) + s4.y);
                o.y = pack_bf2(v[i].z * rstd * gv[i].z * (1.f + c4.z) + s4.z, v[i].w * rstd * gv[i].w * (1.f + c4.w) + s4.w);
                *(uint2*)(hn + (size_t)row * 1024 + i * 256 + lane * 4) = o;
            }
        }
    }
    {
        float* tile = (float*)smem;
        constexpr int J0 = 16 * 38, J1 = J0 + 256, J2 = J1 + 2048, J3 = J2 + 2048, J4 = J3 + 2048, J5 = J4 + 16, J6 = J5 + 8, J7 = J6 + 8;
        for (int it = blockIdx.x; it < J7; it += gridDim.x) {
            if (it < J0) {
                const int rt = it / 38, ctile = it % 38;
                conv_tile64(tile, P.in[I_WIN] + (size_t)layer * 1024 * IN_COLS, IN_COLS, rt * 64, ctile * 64, IN_COLS, (u16*)(ws + WS_WIN), 1024, ctile * 64, 32);
            } else if (it < J1) {
                const int q = it - J0, rt = q >> 4, ctile = q & 15;
                conv_tile64(tile, P.in[I_WOUT] + (size_t)layer * 1024 * 1024, 1024, rt * 64, ctile * 64, 1024, (u16*)(ws + WS_WOUT), 1024, ctile * 64, 32);
            } else if (it < J3) {
                const int up = it >= J2; const int q = it - (up ? J2 : J1);
                const int e = q >> 6, rt = (q >> 2) & 15, ctile = q & 3;
                const float* src = P.in[up ? I_MWUP : I_MWGATE] + ((size_t)layer * 32 + e) * 1024 * 256;
                conv_tile64(tile, src, 256, rt * 64, ctile * 64, 256, (u16*)(ws + WS_WGU) + (size_t)e * 512 * 1024, 1024, ctile * 128 + up * 32, 64);
            } else if (it < J4) {
                const int q = it - J3, e = q >> 6, rt = (q >> 4) & 3, ctile = q & 15;
                const float* src = P.in[I_MWDOWN] + ((size_t)layer * 32 + e) * 256 * 1024;
                conv_tile64(tile, src, 1024, rt * 64, ctile * 64, 1024, (u16*)(ws + WS_WD) + (size_t)e * 1024 * 256, 256, ctile * 64, 32);
            } else if (it < J5) {
                const int q = it - J4, rt = q >> 2, ctile = q & 3;
                conv_tile64(tile, P.in[I_5WGLU] + (size_t)layer * 256 * 256, 256, rt * 64, ctile * 64, 256, (u16*)(ws + WS_WGLU), 256, ctile * 64, 32);
            } else {
                const int uv = it >= J6; const int q = it - (uv ? J6 : J5), rt = q >> 2, ctile = q & 3;
                const float* src = P.in[uv ? I_MWUV : I_MWUK] + (size_t)layer * 128 * 256;
                conv_tile64(tile, src, 256, rt * 64, ctile * 64, 256, (u16*)(ws + WS_WKV), 128, uv * 256 + ctile * 64, 32);
            }
        }
    }
}

DI void ph_gemm_in(const Params& P, unsigned char* smem) {
    unsigned char* ws = P.ws;
    const u16* hn = (const u16*)(ws + WS_HN); const u16* wt = (const u16*)(ws + WS_WIN); u16* pb = (u16*)(ws + WS_P);
    const int lane = opq_tid() & 63;
    constexpr int NT = PC / 128, MT = T / 256;
    for (int tile = blockIdx.x; tile < MT * NT; tile += gridDim.x) {
        const int mt = tile / NT, nt = tile % NT;
        const int m0 = mt * 256, n0 = nt * 128;
        gemm_tile<4, 2, 2, 2>(smem, [&](int r) { return hn + (size_t)(m0 + r) * 1024; }, wt, 1024, n0, 1024,
            [&](f32x16 (&acc)[2][2], int r0, int c0) {
#pragma unroll
                for (int mi = 0; mi < 2; ++mi)
#pragma unroll
                    for (int ni = 0; ni < 2; ++ni) {
                        u16* o = pb + (size_t)(m0 + r0 + mi * 32) * PC + n0 + c0 + ni * 32 + (lane & 31);
#pragma unroll
                        for (int i = 0; i < 16; ++i) o[(size_t)crow(i, lane >> 5) * PC] = f2bf(acc[mi][ni][i]);
                    }
            });
    }
}

constexpr int LDS_TAB = 136 * 1024;
constexpr int LDS_GAIN = LDS_TAB + 8192;
DI float fma_asm(float a, float b, float c) { float d; asm("v_fma_f32 %0, %1, %2, %3" : "=v"(d) : "v"(a), "v"(b), "v"(c)); return d; }
DI void wave_lds_fence() { asm volatile("s_waitcnt lgkmcnt(0)" ::: "memory"); __builtin_amdgcn_wave_barrier(); }

DI void unpack8(const uint4& r, float* x) {
    x[0] = bflo(r.x); x[1] = bfhi(r.x); x[2] = bflo(r.y); x[3] = bfhi(r.y); x[4] = bflo(r.z); x[5] = bfhi(r.z); x[6] = bflo(r.w); x[7] = bfhi(r.w);
}
DI uint4 pack8(const float* x) { uint4 o; o.x = pack_bf2(x[0], x[1]); o.y = pack_bf2(x[2], x[3]); o.z = pack_bf2(x[4], x[5]); o.w = pack_bf2(x[6], x[7]); return o; }
DI void rope32(float* t, const float* cs, int gr, int gc) {
#pragma unroll
    for (int i = 0; i < 8; ++i) {
        const float c = cs[(gr * 8 + i) * 2], s = cs[(gr * 8 + i) * 2 + 1];
        const float a = t[i], b = t[8 + i]; t[i] = a * c - b * s; t[8 + i] = a * s + b * c;
        const float c2 = cs[(gc * 8 + i) * 2], s2 = cs[(gc * 8 + i) * 2 + 1];
        const float a2 = t[16 + i], b2 = t[24 + i]; t[16 + i] = a2 * c2 - b2 * s2; t[24 + i] = a2 * s2 + b2 * c2;
    }
}
DI void rope16(float* t, const float* cs, int pos) {
#pragma unroll
    for (int i = 0; i < 8; ++i) {
        const float c = cs[(pos * 8 + i) * 2], s = cs[(pos * 8 + i) * 2 + 1];
        const float a = t[i], b = t[8 + i]; t[i] = a * c - b * s; t[8 + i] = a * s + b * c;
    }
}

DI void mla_prep_item(const Params& P, int item, unsigned char* smem) {
    unsigned char* ws = P.ws;
    const float* cs = (const float*)(smem + LDS_TAB); const float* gn = (const float*)(smem + LDS_GAIN);
    const float* qn = gn; const float* kn = gn + 96; const float* kvn = gn + 192;
    const int tid = opq_tid(), lane = tid & 63, wave = tid >> 6, r = lane & 31, hh = lane >> 5;
    const int row = item * 256 + wave * 32 + r;
    const int b = row / LSEQ, u = row % LSEQ; const bool lat = u >= CTX; const int l = lat ? u - CTX : 0; const int gr = l >> 6, gc = l & 63;
    const u16* pr = (const u16*)(ws + WS_P) + (size_t)row * PC;
    u16* Qm = (u16*)(ws + WS_QM); u16* Km = (u16*)(ws + WS_KM); u16* Vt = (u16*)(ws + WS_VTM);
    const u16* wkv = (const u16*)(ws + WS_WKV);
    const float qscale = 1.472444460e-01f;
#pragma unroll 1
    for (int hq = 0; hq < 2; ++hq) {
        const int head = 2 * hh + hq;
        uint4 raw[12]; float ss = 0.f;
#pragma unroll
        for (int i = 0; i < 12; ++i) { raw[i] = *(const uint4*)(pr + C_MQ + head * 96 + i * 8); float x[8]; unpack8(raw[i], x);
#pragma unroll
            for (int j = 0; j < 8; ++j) ss += x[j] * x[j]; }
        const float rstd = rsqrtf(ss * (1.f / 96.f) + EPS);
        u16* qo = Qm + ((size_t)(b * 4 + head) * LSEQ + u) * 96;
#pragma unroll
        for (int i = 0; i < 8; ++i) { float x[8]; unpack8(raw[i], x);
#pragma unroll
            for (int j = 0; j < 8; ++j) x[j] = x[j] * rstd * qn[i * 8 + j] * qscale;
            *(uint4*)(qo + i * 8) = pack8(x); }
        float t[32];
#pragma unroll
        for (int i = 0; i < 4; ++i) { float x[8]; unpack8(raw[8 + i], x);
#pragma unroll
            for (int j = 0; j < 8; ++j) t[i * 8 + j] = x[j] * rstd * qn[64 + i * 8 + j]; }
        if (lat) rope32(t, cs, gr, gc);
#pragma unroll
        for (int i = 0; i < 32; ++i) t[i] *= qscale;
#pragma unroll
        for (int i = 0; i < 4; ++i) *(uint4*)(qo + 64 + i * 8) = pack8(t + i * 8);
    }
    bf16x8 cf[8];
    {
        uint4 raw[8]; float ss = 0.f;
#pragma unroll
        for (int s = 0; s < 8; ++s) { raw[s] = *(const uint4*)(pr + C_MCKV + 16 * s + 8 * hh); float x[8]; unpack8(raw[s], x);
#pragma unroll
            for (int j = 0; j < 8; ++j) ss += x[j] * x[j]; }
        ss += __shfl_xor(ss, 32, 64);
        const float rstd = rsqrtf(ss * (1.f / 128.f) + EPS);
#pragma unroll
        for (int s = 0; s < 8; ++s) { float x[8]; unpack8(raw[s], x);
#pragma unroll
            for (int j = 0; j < 8; ++j) x[j] = x[j] * rstd * kvn[16 * s + 8 * hh + j];
            const uint4 pk = pack8(x); cf[s] = __builtin_bit_cast(bf16x8, pk); }
    }
    float kr[16]; float ssr = 0.f;
    {
        const uint4 r0 = *(const uint4*)(pr + C_MKR + 16 * hh), r1 = *(const uint4*)(pr + C_MKR + 16 * hh + 8);
        unpack8(r0, kr); unpack8(r1, kr + 8);
#pragma unroll
        for (int j = 0; j < 16; ++j) ssr += kr[j] * kr[j];
        ssr += __shfl_xor(ssr, 32, 64);
    }
#pragma unroll 1
    for (int hd = 0; hd < 4; ++hd) {
        f32x16 k0 = zero16(), k1 = zero16();
#pragma unroll
        for (int s = 0; s < 8; ++s) {
            const bf16x8 a0 = *(const bf16x8*)(wkv + (size_t)(hd * 64 + r) * 128 + 16 * s + 8 * hh);
            const bf16x8 a1 = *(const bf16x8*)(wkv + (size_t)(hd * 64 + 32 + r) * 128 + 16 * s + 8 * hh);
            k0 = MFMA32(a0, cf[s], k0); k1 = MFMA32(a1, cf[s], k1);
        }
        float ssk = 0.f;
#pragma unroll
        for (int i = 0; i < 16; ++i) ssk += k0[i] * k0[i] + k1[i] * k1[i];
        ssk += __shfl_xor(ssk, 32, 64);
        const float rstd = rsqrtf((ssk + ssr) * (1.f / 96.f) + EPS);
        u16* ko = Km + ((size_t)(b * 4 + hd) * LSEQ + u) * 96;
#pragma unroll
        for (int q4 = 0; q4 < 4; ++q4) {
            const int d0 = 8 * q4 + 4 * hh;
            uint2 o;
            o.x = pack_bf2(k0[4 * q4] * rstd * kn[d0], k0[4 * q4 + 1] * rstd * kn[d0 + 1]);
            o.y = pack_bf2(k0[4 * q4 + 2] * rstd * kn[d0 + 2], k0[4 * q4 + 3] * rstd * kn[d0 + 3]);
            *(uint2*)(ko + d0) = o;
            o.x = pack_bf2(k1[4 * q4] * rstd * kn[32 + d0], k1[4 * q4 + 1] * rstd * kn[32 + d0 + 1]);
            o.y = pack_bf2(k1[4 * q4 + 2] * rstd * kn[32 + d0 + 2], k1[4 * q4 + 3] * rstd * kn[32 + d0 + 3]);
            *(uint2*)(ko + 32 + d0) = o;
        }
        {
            float t[16];
#pragma unroll
            for (int j = 0; j < 16; ++j) t[j] = kr[j] * rstd * kn[64 + 16 * hh + j];
            if (lat) rope16(t, cs, hh ? gc : gr);
            *(uint4*)(ko + 64 + 16 * hh) = pack8(t); *(uint4*)(ko + 64 + 16 * hh + 8) = pack8(t + 8);
        }
        f32x16 v0 = zero16(), v1 = zero16();
#pragma unroll
        for (int s = 0; s < 8; ++s) {
            const bf16x8 a2 = *(const bf16x8*)(wkv + (size_t)(256 + hd * 64 + r) * 128 + 16 * s + 8 * hh);
            const bf16x8 a3 = *(const bf16x8*)(wkv + (size_t)(256 + hd * 64 + 32 + r) * 128 + 16 * s + 8 * hh);
            v0 = MFMA32(a2, cf[s], v0); v1 = MFMA32(a3, cf[s], v1);
        }
        u16* vo = Vt + ((size_t)(b * 4 + hd) * 64) * LSEQ + kpos(u);
#pragma unroll
        for (int i = 0; i < 16; ++i) {
            vo[(size_t)crow(i, hh) * LSEQ] = f2bf(v0[i]);
            vo[(size_t)(32 + crow(i, hh)) * LSEQ] = f2bf(v1[i]);
        }
    }
}

DI void diff_prep_item(const Params& P, int item, unsigned char* smem) {
    unsigned char* ws = P.ws;
    const float* cs = (const float*)(smem + LDS_TAB); const float* gn = (const float*)(smem + LDS_GAIN);
    const int tid = opq_tid(), tokl = tid & 255, part = tid >> 8;
    const int row = item * 256 + tokl;
    const int b = row / LSEQ, u = row % LSEQ; const bool lat = u >= CTX; const int l = lat ? u - CTX : 0; const int gr = l >> 6, gc = l & 63;
    const u16* pr = (const u16*)(ws + WS_P) + (size_t)row * PC;
    {
        const float* g = gn + 320 + part * 32;
        const float scale = part ? 1.f : 2.550348616e-01f;
        const u16* src = pr + (part ? C_DK : C_DQ);
        u16* dst = (u16*)(ws + (part ? WS_KD : WS_QD));
#pragma unroll 1
        for (int head = 0; head < 8; ++head) {
            float t[32]; float ss = 0.f;
#pragma unroll
            for (int i = 0; i < 4; ++i) { const uint4 rr = *(const uint4*)(src + head * 32 + i * 8); unpack8(rr, t + i * 8); }
#pragma unroll
            for (int i = 0; i < 32; ++i) ss += t[i] * t[i];
            const float rstd = rsqrtf(ss * (1.f / 32.f) + EPS);
#pragma unroll
            for (int i = 0; i < 32; ++i) t[i] = t[i] * rstd * g[i];
            if (lat) rope32(t, cs, gr, gc);
#pragma unroll
            for (int i = 0; i < 32; ++i) t[i] *= scale;
            u16* o = dst + ((size_t)(b * 4 + (head >> 1)) * LSEQ + u) * 64 + (head & 1) * 32;
#pragma unroll
            for (int i = 0; i < 4; ++i) *(uint4*)(o + i * 8) = pack8(t + i * 8);
        }
    }
    {
        u16* vt = (u16*)(ws + WS_VTD);
        const int half = part;
#pragma unroll 4
        for (int c8 = 0; c8 < 16; ++c8) {
            const uint4 rr = *(const uint4*)(pr + C_DV + half * 128 + c8 * 8);
            const unsigned wds[4] = {rr.x, rr.y, rr.z, rr.w};
#pragma unroll
            for (int j = 0; j < 8; ++j) {
                const int dim = half * 128 + c8 * 8 + j, hv = dim >> 6, d = dim & 63;
                const u16 val = (u16)((j & 1) ? (wds[j >> 1] >> 16) : (wds[j >> 1] & 0xffffu));
                vt[((size_t)(b * 4 + hv) * 64 + d) * LSEQ + kpos(u)] = val;
            }
        }
    }
}

constexpr int SSD_XT = 0, SSD_BT = 69632, SSD_DTV = 104448, SSD_EV = 108544, SSD_WV = 112640;
DI void ssd_chunk_item(const Params& P, int layer, int ci, unsigned char* smem) {
    unsigned char* ws = P.ws;
    const int tid = opq_tid(), lane = tid & 63, wave = tid >> 6, r = lane & 31, hh = lane >> 5;
    const int b = ci / NCH, c = ci % NCH, u0 = c * 128, row0 = b * LSEQ + u0;
    const u16* pb = (const u16*)(ws + WS_P);
    u16* XT = (u16*)(smem + SSD_XT); u16* BT = (u16*)(smem + SSD_BT);
    float* dtv = (float*)(smem + SSD_DTV); float* Ev = (float*)(smem + SSD_EV); float* wvp = (float*)(smem + SSD_WV);
    {
        const int dir = wave >> 2, h = wave & 3;
        const float a = -expf(P.in[I_SALOG][layer * 8 + dir * 4 + h]);
        const float bias = P.in[I_SDTB][layer * 8 + dir * 4 + h];
        const int t0 = lane, t1 = lane + 64;
        const float r0 = bf2f(pb[(size_t)(row0 + t0) * PC + C_SDT + dir * 4 + h]) + bias;
        const float r1 = bf2f(pb[(size_t)(row0 + t1) * PC + C_SDT + dir * 4 + h]) + bias;
        const float dt0 = r0 > 20.f ? r0 : log1pf(expf(r0)), dt1 = r1 > 20.f ? r1 : log1pf(expf(r1));
        const float dA0 = dt0 * a, dA1 = dt1 * a;
        float s0 = dA0, s1 = dA1;
#pragma unroll
        for (int o = 1; o < 64; o <<= 1) { const float n0 = __shfl_up(s0, o, 64), n1 = __shfl_up(s1, o, 64); if (lane >= o) { s0 += n0; s1 += n1; } }
        const float tot0 = __shfl(s0, 63, 64); s1 += tot0;
        const float total = __shfl(s1, 63, 64);
        const float E0 = dir ? (total - s0 + dA0) : s0, E1 = dir ? (total - s1 + dA1) : s1;
        dtv[wave * 128 + t0] = dt0; dtv[wave * 128 + t1] = dt1;
        Ev[wave * 128 + t0] = E0; Ev[wave * 128 + t1] = E1;
        wvp[wave * 128 + kpos(t0)] = expf(total - E0) * dt0; wvp[wave * 128 + kpos(t1)] = expf(total - E1) * dt1;
        float* gdt = (float*)(ws + WS_SDT); float* ge = (float*)(ws + WS_SE);
        gdt[(size_t)(row0 + t0) * 8 + wave] = dt0; gdt[(size_t)(row0 + t1) * 8 + wave] = dt1;
        ge[(size_t)(row0 + t0) * 8 + wave] = E0; ge[(size_t)(row0 + t1) * 8 + wave] = E1;
        if (lane == 0) ((float*)(ws + WS_SCD))[((b * 2 + dir) * NCH + c) * 4 + h] = expf(total);
    }
    {
        const int cidx = tid;
        const float* cw = P.in[I_SCW] + (size_t)layer * 3 * 512;
        const float w0 = cw[cidx], w1 = cw[512 + cidx], w2 = cw[1024 + cidx], cb = P.in[I_SCB][layer * 512 + cidx];
        const u16* col = pb + (size_t)row0 * PC + C_SXBC + cidx;
        const bool lv = (u0 != 0) && (u0 != CTX), rv = (u0 + 128 != CTX) && (u0 + 128 != LSEQ);
        float prev = lv ? bf2f(col[-(ptrdiff_t)PC]) : 0.f, cur = bf2f(col[0]);
        u16* gx = (u16*)(ws + WS_SXS); u16* gb = (u16*)(ws + WS_SB); u16* gc = (u16*)(ws + WS_SC);
#pragma unroll 4
        for (int t = 0; t < 128; ++t) {
            const float nxt = (t < 127) ? bf2f(col[(size_t)(t + 1) * PC]) : (rv ? bf2f(col[(size_t)128 * PC]) : 0.f);
            const u16 bv = f2bf(silu_f(w0 * prev + w1 * cur + w2 * nxt + cb));
            if (cidx < 256) { gx[(size_t)(row0 + t) * 256 + cidx] = bv; XT[cidx * 136 + kpos(t)] = bv; }
            else if (cidx < 384) { gb[(size_t)(row0 + t) * 128 + cidx - 256] = bv; BT[(cidx - 256) * 136 + kpos(t)] = bv; }
            else gc[(size_t)(row0 + t) * 128 + cidx - 384] = bv;
            prev = cur; cur = nxt;
        }
    }
    __syncthreads();
    {
        const int dir = wave >> 2, h = wave & 3, g = h >> 1;
        f32x16 acc[2][2];
#pragma unroll
        for (int mi = 0; mi < 2; ++mi)
#pragma unroll
            for (int ni = 0; ni < 2; ++ni) acc[mi][ni] = zero16();
#pragma unroll
        for (int s = 0; s < 8; ++s) {
            const float4 wa = *(const float4*)(wvp + wave * 128 + 16 * s + 8 * hh), wb = *(const float4*)(wvp + wave * 128 + 16 * s + 8 * hh + 4);
            const float wts[8] = {wa.x, wa.y, wa.z, wa.w, wb.x, wb.y, wb.z, wb.w};
            bf16x8 aw[2], bb[2];
#pragma unroll
            for (int mi = 0; mi < 2; ++mi) {
                const uint4 rw = *(const uint4*)(XT + (h * 64 + mi * 32 + r) * 136 + 16 * s + 8 * hh);
                float x[8]; unpack8(rw, x);
#pragma unroll
                for (int j = 0; j < 8; ++j) x[j] *= wts[j];
                const uint4 pk = pack8(x); aw[mi] = __builtin_bit_cast(bf16x8, pk);
            }
#pragma unroll
            for (int ni = 0; ni < 2; ++ni) bb[ni] = *(const bf16x8*)(BT + (g * 64 + ni * 32 + r) * 136 + 16 * s + 8 * hh);
#pragma unroll
            for (int mi = 0; mi < 2; ++mi)
#pragma unroll
                for (int ni = 0; ni < 2; ++ni) acc[mi][ni] = MFMA32(aw[mi], bb[ni], acc[mi][ni]);
        }
        float* st = (float*)(ws + WS_SST) + ((size_t)((b * 2 + dir) * NCH + c) * 4 + h) * 4096;
#pragma unroll
        for (int mi = 0; mi < 2; ++mi)
#pragma unroll
            for (int ni = 0; ni < 2; ++ni)
#pragma unroll
                for (int i = 0; i < 16; ++i) st[(mi * 32 + crow(i, hh)) * 64 + ni * 32 + r] = acc[mi][ni][i];
    }
    __syncthreads();
}

constexpr int S5_BU_PITCH = 132;
constexpr int S5_BU_BYTES = 32 * S5_BU_PITCH * 4;
DI void s5_chunk_item(const Params& P, int layer, int ci, unsigned char* smem) {
    unsigned char* ws = P.ws;
    const int tid = opq_tid(), lane = tid & 63, wave = tid >> 6, r = lane & 31, hh = lane >> 5;
    const int b = ci / NCH, c = ci % NCH, row0 = b * LSEQ + c * 128;
    const u16* pb = (const u16*)(ws + WS_P);
    const float* s5a = (const float*)(ws + WS_S5A); const u16* s5bt = (const u16*)(ws + WS_S5BT);
    float* Bu = (float*)(smem + wave * S5_BU_BYTES);
    float* F = (float*)(ws + WS_S5F);
#pragma unroll 1
    for (int gi = 0; gi < 2; ++gi) {
        const int g = wave + 8 * gi;
#pragma unroll 1
        for (int dir = 0; dir < 2; ++dir) {
            const size_t ldg = (size_t)(layer * 2 + dir) * 16 + g;
            const float ar = s5a[(ldg * 64 + lane) * 2], ai = s5a[(ldg * 64 + lane) * 2 + 1], nai = -ai;
            bf16x8 bfr[4];
#pragma unroll
            for (int ct = 0; ct < 4; ++ct) bfr[ct] = *(const bf16x8*)(s5bt + (ldg * 128 + ct * 32 + r) * 16 + 8 * hh);
            float sre = 0.f, sim = 0.f;
#pragma unroll 1
            for (int tbi = 0; tbi < 4; ++tbi) {
                const int tb = dir ? 3 - tbi : tbi;
                const bf16x8 af = *(const bf16x8*)(pb + (size_t)(row0 + tb * 32 + r) * PC + C_S5U + g * 16 + 8 * hh);
#pragma unroll
                for (int ct = 0; ct < 4; ++ct) {
                    const f32x16 acc = MFMA32(af, bfr[ct], zero16());
#pragma unroll
                    for (int i = 0; i < 16; ++i) Bu[crow(i, hh) * S5_BU_PITCH + ct * 32 + r] = acc[i];
                }
                wave_lds_fence();
#pragma unroll 1
                for (int hb = 0; hb < 2; ++hb) {
                    float bre[16], bim[16];
#pragma unroll
                    for (int q = 0; q < 16; ++q) {
                        const int tti = hb * 16 + q, tt = dir ? 31 - tti : tti;
                        bre[q] = Bu[tt * S5_BU_PITCH + lane]; bim[q] = Bu[tt * S5_BU_PITCH + 64 + lane];
                    }
                    wave_lds_fence();
#pragma unroll
                    for (int q = 0; q < 16; ++q) {
                        const float nre = fma_asm(ar, sre, fma_asm(nai, sim, bre[q])), nim = fma_asm(ar, sim, fma_asm(ai, sre, bim[q]));
                        sre = nre; sim = nim;
                    }
                }
                wave_lds_fence();
            }
            float* fo = F + ((((size_t)(b * 2 + dir) * NCH + c) * 16 + g) * 64 + lane) * 2;
            fo[0] = sre; fo[1] = sim;
        }
    }
}

DI void ph_prep(const Params& P, int layer, unsigned char* smem) {
    const int tid = opq_tid();
    {
        float* cs = (float*)(smem + LDS_TAB); float* gn = (float*)(smem + LDS_GAIN);
        for (int i = tid; i < 1024; i += NTHR) {
            const int pos = i >> 3, f = i & 7;
            const float inv = expf(-(float)f * (9.210340371976184f / 8.f));
            float sn, cn; sincosf((float)pos * inv, &sn, &cn);
            cs[i * 2] = cn; cs[i * 2 + 1] = sn;
        }
        if (tid < 96) { gn[tid] = P.in[I_MQN][layer * 96 + tid]; gn[96 + tid] = P.in[I_MKN][layer * 96 + tid]; }
        if (tid < 128) gn[192 + tid] = P.in[I_MKVN][layer * 128 + tid];
        if (tid < 32) { gn[320 + tid] = P.in[I_DQN][layer * 32 + tid]; gn[352 + tid] = P.in[I_DKN][layer * 32 + tid]; }
        __syncthreads();
    }
    for (int it = blockIdx.x; it < 396; it += gridDim.x) {
        if (it < 132) s5_chunk_item(P, layer, it, smem);
        else if (it < 264) ssd_chunk_item(P, layer, it - 132, smem);
        else if (it < 330) mla_prep_item(P, it - 264, smem);
        else diff_prep_item(P, it - 330, smem);
        __syncthreads();
    }
}

constexpr int VP = 144;
constexpr int ATT_STAGE = 64 * 208 + 64 * VP;

template <int DK>
DI void attn_pass(const u16* __restrict__ Qg, const u16* __restrict__ Kg, int pitch, const u16* __restrict__ Vg, int qrow, int nkt,
                  float negbound, unsigned char* smem, float (&outv)[2][16]) {
    const int tid = opq_tid(), lane = tid & 63, r = lane & 31, hh = lane >> 5;
    constexpr int KP = DK * 2 + 16;
    constexpr int KCH = DK / 8;
    constexpr int NKC = 64 * KCH;
    constexpr int NQF = DK / 16;
    bf16x8 qf[NQF];
#pragma unroll
    for (int s = 0; s < NQF; ++s) qf[s] = *(const bf16x8*)(Qg + (size_t)qrow * pitch + 16 * s + 8 * hh);
    const int kc0 = tid, kc1 = tid + 512;
    const int k_row0 = kc0 / KCH, k_col0 = kc0 % KCH, k_row1 = kc1 / KCH, k_col1 = kc1 % KCH;
    const int v_row = tid >> 3, v_col = tid & 7;
    uint4 rk0 = make_uint4(0, 0, 0, 0), rk1 = make_uint4(0, 0, 0, 0), rv;
    auto load_tile = [&](int kt) {
        const size_t key0 = (size_t)kt * 64;
        if (kc0 < NKC) rk0 = *(const uint4*)(Kg + (key0 + k_row0) * pitch + k_col0 * 8);
        if (kc1 < NKC) rk1 = *(const uint4*)(Kg + (key0 + k_row1) * pitch + k_col1 * 8);
        rv = *(const uint4*)(Vg + (size_t)v_row * LSEQ + key0 + v_col * 8);
    };
    auto store_tile = [&](int st) {
        unsigned char* sb = smem + st * ATT_STAGE;
        if (kc0 < NKC) *(uint4*)(sb + k_row0 * KP + k_col0 * 16) = rk0;
        if (kc1 < NKC) *(uint4*)(sb + k_row1 * KP + k_col1 * 16) = rk1;
        *(uint4*)(sb + 64 * KP + v_row * VP + v_col * 16) = rv;
    };
    f32x16 o[2]; o[0] = zero16(); o[1] = zero16();
    float l = 0.f;
    load_tile(0); store_tile(0);
    __syncthreads();
#pragma unroll 2
    for (int kt = 0; kt < nkt; ++kt) {
        const unsigned char* sb = smem + (kt & 1) * ATT_STAGE;
        const unsigned char* vb = sb + 64 * KP;
        if (kt + 1 < nkt) load_tile(kt + 1);
#pragma unroll
        for (int k2 = 0; k2 < 2; ++k2) {
            f32x16 sacc;
#pragma unroll
            for (int i = 0; i < 16; ++i) sacc[i] = negbound;
#pragma unroll
            for (int s = 0; s < NQF; ++s) sacc = MFMA32(ld_frag(sb + (k2 * 32 + r) * KP + s * 32 + hh * 16), qf[s], sacc);
            float pv[16];
#pragma unroll
            for (int i = 0; i < 16; ++i) { pv[i] = __builtin_amdgcn_exp2f(sacc[i]); l += pv[i]; }
            const uint4 a = pack8(pv), c = pack8(pv + 8);
            const bf16x8 pf0 = __builtin_bit_cast(bf16x8, a), pf1 = __builtin_bit_cast(bf16x8, c);
#pragma unroll
            for (int dt = 0; dt < 2; ++dt) {
                o[dt] = MFMA32(ld_frag(vb + (dt * 32 + r) * VP + (2 * k2) * 32 + hh * 16), pf0, o[dt]);
                o[dt] = MFMA32(ld_frag(vb + (dt * 32 + r) * VP + (2 * k2 + 1) * 32 + hh * 16), pf1, o[dt]);
            }
        }
        if (kt + 1 < nkt) store_tile((kt + 1) & 1);
        __syncthreads();
    }
    l += __shfl_xor(l, 32, 64);
    const float il = 1.f / l;
#pragma unroll
    for (int dt = 0; dt < 2; ++dt)
#pragma unroll
        for (int i = 0; i < 16; ++i) outv[dt][i] = o[dt][i] * il;
}

template <bool MLA>
DI void attn_item(const Params& P, int layer, int b, int head, int qt, float negbound, float lam, float lam_init, unsigned char* smem) {
    unsigned char* ws = P.ws;
    const int tid = opq_tid(), lane = tid & 63, wave = tid >> 6, r = lane & 31, hh = lane >> 5;
    constexpr int PITCH = MLA ? 96 : 64;
    const u16* Qg = (const u16*)(ws + (MLA ? WS_QM : WS_QD)) + (size_t)(b * 4 + head) * LSEQ * PITCH;
    const u16* Kg = (const u16*)(ws + (MLA ? WS_KM : WS_KD)) + (size_t)(b * 4 + head) * LSEQ * PITCH;
    const u16* Vg = (const u16*)(ws + (MLA ? WS_VTM : WS_VTD)) + (size_t)(b * 4 + head) * 64 * LSEQ;
    const int q0 = qt * 256;
    const int nkt = (qt == 0) ? (CTX / 64) : (LSEQ / 64);
    const int qrow = q0 + wave * 32 + r;
    float outv[2][16];
    if (MLA) {
        attn_pass<96>(Qg, Kg, 96, Vg, qrow, nkt, negbound, smem, outv);
    } else {
        float o1[2][16];
        attn_pass<32>(Qg, Kg, 64, Vg, qrow, nkt, negbound, smem, o1);
        attn_pass<32>(Qg + 32, Kg + 32, 64, Vg, qrow, nkt, negbound, smem, outv);
        float ss = 0.f;
#pragma unroll
        for (int dt = 0; dt < 2; ++dt)
#pragma unroll
            for (int i = 0; i < 16; ++i) { const float v = o1[dt][i] - lam * outv[dt][i]; outv[dt][i] = v; ss += v * v; }
        ss += __shfl_xor(ss, 32, 64);
        const float rstd = rsqrtf(ss * (1.f / 64.f) + EPS) * (1.f - lam_init);
        const float* sub = P.in[I_DSUB] + layer * 64;
#pragma unroll
        for (int dt = 0; dt < 2; ++dt)
#pragma unroll
            for (int i = 0; i < 16; ++i) outv[dt][i] *= rstd * sub[dt * 32 + crow(i, hh)];
    }
    unsigned char* ob = smem + wave * (32 * 144);
#pragma unroll
    for (int dt = 0; dt < 2; ++dt)
#pragma unroll
        for (int q4 = 0; q4 < 4; ++q4) {
            uint2 w;
            w.x = pack_bf2(outv[dt][4 * q4], outv[dt][4 * q4 + 1]); w.y = pack_bf2(outv[dt][4 * q4 + 2], outv[dt][4 * q4 + 3]);
            *(uint2*)(ob + r * 144 + (dt * 32 + 8 * q4 + 4 * hh) * 2) = w;
        }
    wave_lds_fence();
    u16* cat = (u16*)(ws + WS_CAT);
    const int colbase = (MLA ? 0 : 768) + head * 64;
#pragma unroll
    for (int it = 0; it < 4; ++it) {
        const int idx = it * 64 + lane, qr = idx >> 3, ch = idx & 7;
        const uint4 v = *(const uint4*)(ob + qr * 144 + ch * 16);
        const size_t row = (size_t)b * LSEQ + q0 + wave * 32 + qr;
        *(uint4*)(cat + row * 1024 + colbase + ch * 8) = v;
    }
    __syncthreads();
}

DI void ph_attn(const Params& P, int layer, unsigned char* smem) {
    unsigned char* ws = P.ws;
    const int tid = opq_tid();
    if (blockIdx.x < 128) {
        const int e = blockIdx.x * NTHR + tid;
        const int el = e & 4095, h = (e >> 12) & 3, dir = (e >> 14) & 1, b = e >> 15;
        float* st = (float*)(ws + WS_SST); const float* cd = (const float*)(ws + WS_SCD);
        float hc = 0.f;
#pragma unroll 6
        for (int k = 0; k < NCH; ++k) {
            const int c = chunk_at(dir, k);
            const size_t off = ((size_t)((b * 2 + dir) * NCH + c) * 4 + h) * 4096 + el;
            const float s = st[off];
            st[off] = hc;
            hc = hc * cd[((b * 2 + dir) * NCH + c) * 4 + h] + s;
        }
    } else if (blockIdx.x < 136) {
        const int e = (blockIdx.x - 128) * NTHR + tid;
        const int p = e & 63, g = (e >> 6) & 15, dir = (e >> 10) & 1, b = e >> 11;
        const float* s5a = (const float*)(ws + WS_S5A);
        const size_t ldg = (size_t)(layer * 2 + dir) * 16 + g;
        float ar = s5a[(ldg * 64 + p) * 2], ai = s5a[(ldg * 64 + p) * 2 + 1];
#pragma unroll
        for (int q = 0; q < 7; ++q) { const float nr = ar * ar - ai * ai, ni = 2.f * ar * ai; ar = nr; ai = ni; }
        float* F = (float*)(ws + WS_S5F);
        float cr = 0.f, cim = 0.f;
#pragma unroll 6
        for (int k = 0; k < NCH; ++k) {
            const int c = chunk_at(dir, k);
            float* fo = F + ((((size_t)(b * 2 + dir) * NCH + c) * 16 + g) * 64 + p) * 2;
            const float fr = fo[0], fi = fo[1];
            fo[0] = cr; fo[1] = cim;
            const float nr = ar * cr - ai * cim + fr, ni = ar * cim + ai * cr + fi;
            cr = nr; cim = ni;
        }
    }
    float nb_m, nb_d, lam;
    {
        const int lane = tid & 63;
        float m = fabsf(P.in[I_MQN][layer * 96 + lane] * P.in[I_MKN][layer * 96 + lane]);
        if (lane < 32) m = fmaxf(m, fabsf(P.in[I_MQN][layer * 96 + 64 + lane] * P.in[I_MKN][layer * 96 + 64 + lane]));
        float m2 = 0.f, s1 = 0.f, s2 = 0.f;
        if (lane < 32) {
            m2 = fabsf(P.in[I_DQN][layer * 32 + lane] * P.in[I_DKN][layer * 32 + lane]);
            s1 = P.in[I_DLQ1][layer * 32 + lane] * P.in[I_DLK1][layer * 32 + lane];
            s2 = P.in[I_DLQ2][layer * 32 + lane] * P.in[I_DLK2][layer * 32 + lane];
        }
#pragma unroll
        for (int o = 32; o >= 1; o >>= 1) {
            m = fmaxf(m, __shfl_xor(m, o, 64)); m2 = fmaxf(m2, __shfl_xor(m2, o, 64));
            s1 += __shfl_xor(s1, o, 64); s2 += __shfl_xor(s2, o, 64);
        }
        nb_m = -(m * 1.413546682e+01f);
        nb_d = -(m2 * 8.161115573e+00f);
        lam = expf(s1) - expf(s2) + (0.8f - 0.6f * expf(-0.3f * (float)layer));
    }
    const float lam_init = 0.8f - 0.6f * expf(-0.3f * (float)layer);
    __syncthreads();
    for (int it = blockIdx.x; it < 528; it += gridDim.x) {
        const int idx = (it < 264) ? it : it - 264;
        const int b = (idx & 7) >> 2, head = idx & 3, qt = ((idx >> 3) + 1) % 33;
        if (it < 264) attn_item<false>(P, layer, b, head, qt, nb_d, lam, lam_init, smem);
        else          attn_item<true>(P, layer, b, head, qt, nb_m, 0.f, 0.f, smem);
    }
}

constexpr int SO_B = 0, SO_C = 36864, SO_XT = 73728, SO_E = 143360, SO_DT = 147456;
constexpr int SO_YP = 528;
DI void ssd_out_item(const Params& P, int layer, int ci, unsigned char* smem) {
    unsigned char* ws = P.ws;
    const int tid = opq_tid(), lane = tid & 63, wave = tid >> 6, r = lane & 31, hh = lane >> 5;
    const int b = ci / NCH, c = ci % NCH, row0 = b * LSEQ + c * 128;
    unsigned char* Bm = smem + SO_B; unsigned char* Cm = smem + SO_C; u16* XT = (u16*)(smem + SO_XT);
    float* Es = (float*)(smem + SO_E); float* dts = (float*)(smem + SO_DT);
    {
        const u16* gb = (const u16*)(ws + WS_SB); const u16* gc = (const u16*)(ws + WS_SC); const u16* gx = (const u16*)(ws + WS_SXS);
#pragma unroll
        for (int it = 0; it < 4; ++it) {
            const int idx = it * NTHR + tid, t = idx >> 4, cch = idx & 15, g = cch >> 3, n8 = cch & 7;
            *(uint4*)(Bm + g * 18432 + t * 144 + n8 * 16) = *(const uint4*)(gb + (size_t)(row0 + t) * 128 + cch * 8);
            *(uint4*)(Cm + g * 18432 + t * 144 + n8 * 16) = *(const uint4*)(gc + (size_t)(row0 + t) * 128 + cch * 8);
        }
#pragma unroll 2
        for (int it = 0; it < 8; ++it) {
            const int idx = it * NTHR + tid, cc = idx & 255, kq = idx >> 8;
            const int k16 = kq >> 1, hb = kq & 1;
            const u16* src = gx + (size_t)(row0 + 16 * k16 + 4 * hb) * 256 + cc;
            uint4 o;
            o.x = (unsigned)src[0] | ((unsigned)src[256] << 16);
            o.y = (unsigned)src[512] | ((unsigned)src[768] << 16);
            o.z = (unsigned)src[8 * 256] | ((unsigned)src[9 * 256] << 16);
            o.w = (unsigned)src[10 * 256] | ((unsigned)src[11 * 256] << 16);
            *(uint4*)(XT + cc * 136 + 16 * k16 + 8 * hb) = o;
        }
        const float* ge = (const float*)(ws + WS_SE); const float* gdt = (const float*)(ws + WS_SDT);
#pragma unroll
        for (int it = 0; it < 2; ++it) {
            const int idx = it * NTHR + tid, t = idx >> 3, w = idx & 7;
            Es[w * 128 + t] = ge[(size_t)(row0 + t) * 8 + w];
            dts[w * 128 + t] = gdt[(size_t)(row0 + t) * 8 + w];
        }
    }
    __syncthreads();
    const int h = wave & 3, th = wave >> 2, g = h >> 1;
    f32x16 Y[2][2];
#pragma unroll
    for (int a = 0; a < 2; ++a)
#pragma unroll
        for (int q = 0; q < 2; ++q) Y[a][q] = zero16();
    const unsigned char* Bg = Bm + g * 18432; const unsigned char* Cg = Cm + g * 18432;
#pragma unroll 1
    for (int dir = 0; dir < 2; ++dir) {
        const int w = dir * 4 + h;
        bf16x8 hf[2][4];
        {
            const float* hin = (const float*)(ws + WS_SST) + ((size_t)((b * 2 + dir) * NCH + c) * 4 + h) * 4096;
#pragma unroll
            for (int pt = 0; pt < 2; ++pt)
#pragma unroll
                for (int s = 0; s < 4; ++s) {
                    const float4 x0 = *(const float4*)(hin + (pt * 32 + r) * 64 + 16 * s + 8 * hh), x1 = *(const float4*)(hin + (pt * 32 + r) * 64 + 16 * s + 8 * hh + 4);
                    uint4 pk; pk.x = pack_bf2(x0.x, x0.y); pk.y = pack_bf2(x0.z, x0.w); pk.z = pack_bf2(x1.x, x1.y); pk.w = pack_bf2(x1.z, x1.w);
                    hf[pt][s] = __builtin_bit_cast(bf16x8, pk);
                }
        }
#pragma unroll
        for (int tti = 0; tti < 2; ++tti) {
            const int tt = 2 * th + tti, t = tt * 32 + r;
            const float Et = Es[w * 128 + t];
            bf16x8 cq[4];
#pragma unroll
            for (int s = 0; s < 4; ++s) cq[s] = ld_frag(Cg + t * 144 + s * 32 + hh * 16);
            const int jlo = dir ? tt : 0, jhi = dir ? 3 : tt;
#pragma unroll 1
            for (int jt = jlo; jt <= jhi; ++jt) {
                f32x16 ga = zero16();
#pragma unroll
                for (int s = 0; s < 4; ++s) ga = MFMA32(ld_frag(Bg + (jt * 32 + r) * 144 + s * 32 + hh * 16), cq[s], ga);
                float lv[16];
#pragma unroll
                for (int i = 0; i < 16; ++i) {
                    const int j = jt * 32 + crow(i, hh);
                    const bool valid = dir ? (j >= t) : (j <= t);
                    const float arg = valid ? (Et - Es[w * 128 + j]) : 0.f;
                    lv[i] = valid ? ga[i] * __expf(arg) * dts[w * 128 + j] : 0.f;
                }
                const uint4 p0 = pack8(lv), p1 = pack8(lv + 8);
                const bf16x8 lf0 = __builtin_bit_cast(bf16x8, p0), lf1 = __builtin_bit_cast(bf16x8, p1);
#pragma unroll
                for (int pt = 0; pt < 2; ++pt) {
                    const u16* xr = XT + (h * 64 + pt * 32 + r) * 136 + 32 * jt + 8 * hh;
                    Y[pt][tti] = MFMA32(*(const bf16x8*)(xr), lf0, Y[pt][tti]);
                    Y[pt][tti] = MFMA32(*(const bf16x8*)(xr + 16), lf1, Y[pt][tti]);
                }
            }
            const float sc = __expf(Et);
#pragma unroll
            for (int pt = 0; pt < 2; ++pt) {
                f32x16 ho = zero16();
#pragma unroll
                for (int s = 0; s < 4; ++s) ho = MFMA32(hf[pt][s], cq[s], ho);
#pragma unroll
                for (int i = 0; i < 16; ++i) Y[pt][tti][i] += sc * ho[i];
            }
        }
    }
    {
        const float dsk = P.in[I_SD][layer * 4 + h];
#pragma unroll
        for (int tti = 0; tti < 2; ++tti) {
            const int t = (2 * th + tti) * 32 + r;
#pragma unroll
            for (int pt = 0; pt < 2; ++pt)
#pragma unroll
                for (int i = 0; i < 16; ++i) Y[pt][tti][i] += dsk * bf2f(XT[(h * 64 + pt * 32 + crow(i, hh)) * 136 + kpos(t)]);
        }
    }
    __syncthreads();
    {
        unsigned char* Ys = smem + SO_XT;
#pragma unroll
        for (int tti = 0; tti < 2; ++tti) {
            const int t = (2 * th + tti) * 32 + r;
#pragma unroll
            for (int pt = 0; pt < 2; ++pt)
#pragma unroll
                for (int q4 = 0; q4 < 4; ++q4) {
                    uint2 o; o.x = pack_bf2(Y[pt][tti][4 * q4], Y[pt][tti][4 * q4 + 1]); o.y = pack_bf2(Y[pt][tti][4 * q4 + 2], Y[pt][tti][4 * q4 + 3]);
                    *(uint2*)(Ys + t * SO_YP + (h * 64 + pt * 32 + 8 * q4 + 4 * hh) * 2) = o;
                }
        }
    }
    __syncthreads();
    {
        const unsigned char* Ys = smem + SO_XT;
        const u16* pb = (const u16*)(ws + WS_P); u16* cat = (u16*)(ws + WS_CAT);
        const int c8 = tid & 31, tl = tid >> 5;
        float gn[8];
#pragma unroll
        for (int j = 0; j < 8; ++j) gn[j] = P.in[I_SNORM][layer * 256 + c8 * 8 + j];
#pragma unroll 2
        for (int it = 0; it < 8; ++it) {
            const int t = it * 16 + tl;
            const uint4 yr = *(const uint4*)(Ys + t * SO_YP + c8 * 16);
            const uint4 zr = *(const uint4*)(pb + (size_t)(row0 + t) * PC + C_SZ + c8 * 8);
            float y[8], z[8]; unpack8(yr, y); unpack8(zr, z);
            float ss = 0.f;
#pragma unroll
            for (int j = 0; j < 8; ++j) { y[j] *= silu_f(z[j]); ss += y[j] * y[j]; }
#pragma unroll
            for (int o = 16; o >= 1; o >>= 1) ss += __shfl_xor(ss, o, 64);
            const float rstd = rsqrtf(ss * (1.f / 256.f) + EPS);
#pragma unroll
            for (int j = 0; j < 8; ++j) y[j] *= rstd * gn[j];
            *(uint4*)(cat + (size_t)(row0 + t) * 1024 + 256 + c8 * 8) = pack8(y);
        }
    }
    __syncthreads();
}

DI float gelu_tanh(float x) {
    const float z = 0.7978845608028654f * (x + 0.044715f * x * x * x);
    const float th = 1.f - 2.f / (1.f + __expf(2.f * z));
    return 0.5f * x * (1.f + th);
}

typedef __attribute__((ext_vector_type(4))) float f32x4;
#define MFMA16(a, b, c) __builtin_amdgcn_mfma_f32_16x16x32_bf16((a), (b), (c), 0, 0, 0)
DI void s5_out_item(const Params& P, int layer, int ci, unsigned char* smem) {
    unsigned char* ws = P.ws;
    const int tid = opq_tid(), lane = tid & 63, wave = tid >> 6, r = lane & 31, hh = lane >> 5;
    const int r16 = lane & 15, kq = lane >> 4;
    const int b = ci / NCH, c = ci % NCH, row0 = b * LSEQ + c * 128;
    const u16* pb = (const u16*)(ws + WS_P);
    const float* s5a = (const float*)(ws + WS_S5A); const u16* s5bt = (const u16*)(ws + WS_S5BT); const u16* s5ct = (const u16*)(ws + WS_S5CT);
    float* Bu = (float*)(smem + wave * S5_BU_BYTES);
    const float* F = (const float*)(ws + WS_S5F);
    u16* Gg = (u16*)(ws + WS_HID);
#pragma unroll 1
    for (int gi = 0; gi < 2; ++gi) {
        const int g = wave + 8 * gi;
        f32x4 yv[4][2];
#pragma unroll
        for (int q = 0; q < 4; ++q) { yv[q][0] = (f32x4){0.f, 0.f, 0.f, 0.f}; yv[q][1] = (f32x4){0.f, 0.f, 0.f, 0.f}; }
        bf16x8 dfrag;
        {
            const unsigned dv = (unsigned)f2bf(P.in[I_5D][layer * 256 + g * 16 + r16]);
            unsigned w[4];
#pragma unroll
            for (int q = 0; q < 4; ++q) {
                const int k0 = 8 * kq + 2 * q;
                w[q] = (k0 == r16) ? dv : ((k0 + 1 == r16) ? (dv << 16) : 0u);
            }
            const uint4 dq = make_uint4(w[0], w[1], w[2], w[3]);
            dfrag = __builtin_bit_cast(bf16x8, dq);
        }
#pragma unroll
        for (int dir = 0; dir < 2; ++dir) {
            asm volatile("" ::: "memory");
            const size_t ldg = (size_t)(layer * 2 + dir) * 16 + g;
            const float ar = s5a[(ldg * 64 + lane) * 2], ai = s5a[(ldg * 64 + lane) * 2 + 1], nai = -ai;
            bf16x8 bfr[4], cfr[4];
#pragma unroll
            for (int ct = 0; ct < 4; ++ct) bfr[ct] = *(const bf16x8*)(s5bt + (ldg * 128 + ct * 32 + r) * 16 + 8 * hh);
#pragma unroll
            for (int s4 = 0; s4 < 4; ++s4) cfr[s4] = *(const bf16x8*)(s5ct + (ldg * 16 + r16) * 128 + 32 * s4 + 8 * kq);
            const float* fi = F + ((((size_t)(b * 2 + dir) * NCH + c) * 16 + g) * 64 + lane) * 2;
            float sre = fi[0], sim = fi[1];
#pragma unroll
            for (int tbi = 0; tbi < 4; ++tbi) {
                const int tb = dir ? 3 - tbi : tbi;
                const bf16x8 af = *(const bf16x8*)(pb + (size_t)(row0 + tb * 32 + r) * PC + C_S5U + g * 16 + 8 * hh);
#pragma unroll
                for (int ct = 0; ct < 4; ++ct) {
                    const f32x16 acc = MFMA32(af, bfr[ct], zero16());
#pragma unroll
                    for (int i = 0; i < 16; ++i) Bu[crow(i, hh) * S5_BU_PITCH + ct * 32 + r] = acc[i];
                }
                wave_lds_fence();
#pragma unroll 1
                for (int hb = 0; hb < 2; ++hb) {
                    float bre[16], bim[16];
#pragma unroll
                    for (int q = 0; q < 16; ++q) {
                        const int tti = hb * 16 + q, tt = dir ? 31 - tti : tti;
                        bre[q] = Bu[tt * S5_BU_PITCH + lane]; bim[q] = Bu[tt * S5_BU_PITCH + 64 + lane];
                    }
                    wave_lds_fence();
#pragma unroll
                    for (int q = 0; q < 16; ++q) {
                        const int tti = hb * 16 + q, tt = dir ? 31 - tti : tti;
                        const float nre = fma_asm(ar, sre, fma_asm(nai, sim, bre[q])), nim = fma_asm(ar, sim, fma_asm(ai, sre, bim[q]));
                        sre = nre; sim = nim;
                        Bu[tt * S5_BU_PITCH + lane] = __uint_as_float(pack_bf2(sre, sim));
                    }
                }
                wave_lds_fence();
#pragma unroll
                for (int ts = 0; ts < 2; ++ts) {
#pragma unroll
                    for (int s4 = 0; s4 < 4; ++s4)
                        yv[tb][ts] = MFMA16(ld_frag((const unsigned char*)Bu + (ts * 16 + r16) * (S5_BU_PITCH * 4) + s4 * 64 + kq * 16), cfr[s4], yv[tb][ts]);
                    if (dir == 0) {
                        uint4 uz = make_uint4(0, 0, 0, 0);
                        if (kq < 2) uz = *(const uint4*)(pb + (size_t)(row0 + tb * 32 + ts * 16 + r16) * PC + C_S5U + g * 16 + 8 * kq);
                        yv[tb][ts] = MFMA16(__builtin_bit_cast(bf16x8, uz), dfrag, yv[tb][ts]);
                    }
                }
                wave_lds_fence();
            }
        }
        {
            int gofs = (row0 + 4 * kq) * 256 + g * 16 + r16;
            asm volatile("" : "+v"(gofs));
            u16* gp = Gg + gofs;
#pragma unroll
            for (int tb = 0; tb < 4; ++tb)
#pragma unroll
                for (int ts = 0; ts < 2; ++ts)
#pragma unroll
                    for (int i = 0; i < 4; ++i) gp[(tb * 32 + ts * 16 + i) * 256] = f2bf(gelu_tanh(yv[tb][ts][i]));
        }
    }
    __syncthreads();
    unsigned char* G = smem;
#pragma unroll
    for (int it = 0; it < 8; ++it) {
        const int idx = it * NTHR + tid, t = idx >> 5, c8 = idx & 31;
        *(uint4*)(G + t * 528 + c8 * 16) = *(const uint4*)(Gg + (size_t)(row0 + t) * 256 + c8 * 8);
    }
    __syncthreads();
    {
        const int tq = wave & 3, nh = wave >> 2;
        const u16* wg = (const u16*)(ws + WS_WGLU);
        f32x16 acc[4];
#pragma unroll
        for (int ni = 0; ni < 4; ++ni) acc[ni] = zero16();
#pragma unroll 4
        for (int s = 0; s < 16; ++s) {
            const bf16x8 a = ld_frag(G + (tq * 32 + r) * 528 + s * 32 + hh * 16);
#pragma unroll
            for (int ni = 0; ni < 4; ++ni)
                acc[ni] = MFMA32(a, *(const bf16x8*)(wg + (size_t)(nh * 128 + ni * 32 + r) * 256 + 16 * s + 8 * hh), acc[ni]);
        }
        u16* cat = (u16*)(ws + WS_CAT);
#pragma unroll
        for (int ni = 0; ni < 4; ++ni) {
            const int n = nh * 128 + ni * 32 + r;
            const float bg = P.in[I_5BGLU][layer * 256 + n];
#pragma unroll
            for (int i = 0; i < 16; ++i) {
                const int t = tq * 32 + crow(i, hh);
                const float gv = bf2f(*(const u16*)(G + t * 528 + n * 2));
                const float o = gv / (1.f + __expf(-(acc[ni][i] + bg)));
                cat[(size_t)(row0 + t) * 1024 + 512 + n] = f2bf(o);
            }
        }
    }
    __syncthreads();
}

DI void ph_ssm_out(const Params& P, int layer, unsigned char* smem) {
    for (int it = blockIdx.x; it < 264; it += gridDim.x) {
        if (it < 132) s5_out_item(P, layer, it, smem);
        else ssd_out_item(P, layer, it - 132, smem);
    }
}

DI void ph_gemm_out(const Params& P, int layer, unsigned char* smem) {
    unsigned char* ws = P.ws;
    const u16* cat = (const u16*)(ws + WS_CAT); const u16* wt = (const u16*)(ws + WS_WOUT); float* xb = (float*)(ws + WS_X);
    const float* mods = (const float*)(ws + WS_MODS);
    const int lane = opq_tid() & 63;
    for (int tile = blockIdx.x; tile < (T / 128) * 8; tile += gridDim.x) {
        const int mt = tile >> 3, nt = tile & 7, m0 = mt * 128, n0 = nt * 128;
        const int b = m0 / LSEQ, u = m0 % LSEQ, which = (u < CTX) ? 2 : b;
        const float* gate = mods + ((size_t)layer * 3 + which) * 6144 + 2 * 1024;
        gemm_tile<2, 4, 2, 1>(smem, [&](int r) { return cat + (size_t)(m0 + r) * 1024; }, wt, 1024, n0, 1024,
            [&](f32x16 (&acc)[2][1], int r0, int c0) {
                const int col = n0 + c0 + (lane & 31);
                const float gt = gate[col];
#pragma unroll
                for (int mi = 0; mi < 2; ++mi)
#pragma unroll
                    for (int i = 0; i < 16; ++i) {
                        float* xp = xb + (size_t)(m0 + r0 + mi * 32 + crow(i, lane >> 5)) * 1024 + col;
                        *xp += gt * acc[mi][0][i];
                    }
            });
    }
}

DI void ph_norm2_route(const Params& P, int layer, unsigned char* smem) {
    unsigned char* ws = P.ws;
    const int tid = opq_tid(), lane = tid & 63, wave = tid >> 6;
    float* wr = (float*)smem;
    {
        const float* wg = P.in[I_MWG] + (size_t)layer * 1024 * 4; const float* we = P.in[I_MWE] + (size_t)layer * 4 * 1024 * 8;
        for (int i = tid; i < 4096; i += NTHR) { const int k = i >> 2, o = i & 3; wr[o * 1024 + k] = wg[i]; }
        for (int i = tid; i < 32768; i += NTHR) { const int e = i & 7, k = (i >> 3) & 1023, g = i >> 13; wr[(4 + g * 8 + e) * 1024 + k] = we[i]; }
    }
    __syncthreads();
    const float* xbuf = (const float*)(ws + WS_X); u16* hn = (u16*)(ws + WS_HN);
    const float* mods = (const float*)(ws + WS_MODS);
    const float* g2n = P.in[I_NORM2] + layer * 1024;
    int* tok_e = (int*)(ws + WS_TOKE); float* tok_w = (float*)(ws + WS_TOKW); int* list = (int*)(ws + WS_LIST);
    int* cnt = (int*)(ws + WS_CTL + CTL_CNT_OFF) + layer * 32;
    float4 gv[4];
#pragma unroll
    for (int i = 0; i < 4; ++i) gv[i] = *(const float4*)(g2n + i * 256 + lane * 4);
    for (int row = blockIdx.x * NWAVE + wave; row < T; row += gridDim.x * NWAVE) {
        const int b = row / LSEQ, u = row % LSEQ, which = (u < CTX) ? 2 : b;
        const float* xr = xbuf + (size_t)row * 1024;
        float4 v[4]; float ss = 0.f;
#pragma unroll
        for (int i = 0; i < 4; ++i) { v[i] = *(const float4*)(xr + i * 256 + lane * 4); ss += v[i].x * v[i].x + v[i].y * v[i].y + v[i].z * v[i].z + v[i].w * v[i].w; }
        ss = wave_sum(ss);
        const float rstd = rsqrtf(ss * (1.f / 1024.f) + EPS);
        const float* sh = mods + ((size_t)layer * 3 + which) * 6144 + 3 * 1024; const float* sc = sh + 1024;
#pragma unroll
        for (int i = 0; i < 4; ++i) {
            const float4 s4 = *(const float4*)(sh + i * 256 + lane * 4), c4 = *(const float4*)(sc + i * 256 + lane * 4);
            v[i].x = v[i].x * rstd * gv[i].x * (1.f + c4.x) + s4.x; v[i].y = v[i].y * rstd * gv[i].y * (1.f + c4.y) + s4.y;
            v[i].z = v[i].z * rstd * gv[i].z * (1.f + c4.z) + s4.z; v[i].w = v[i].w * rstd * gv[i].w * (1.f + c4.w) + s4.w;
            uint2 o; o.x = pack_bf2(v[i].x, v[i].y); o.y = pack_bf2(v[i].z, v[i].w);
            *(uint2*)(hn + (size_t)row * 1024 + i * 256 + lane * 4) = o;
        }
        auto dotw = [&](int o) {
            float a = 0.f;
#pragma unroll
            for (int i = 0; i < 4; ++i) { const float4 w4 = *(const float4*)(wr + o * 1024 + i * 256 + lane * 4); a += v[i].x * w4.x + v[i].y * w4.y + v[i].z * w4.z + v[i].w * w4.w; }
            return wave_sum(a);
        };
        float lg[4];
#pragma unroll
        for (int o = 0; o < 4; ++o) lg[o] = dotw(o) + P.in[I_MBG][layer * 4 + o];
        int gi = 0; float gm = lg[0];
#pragma unroll
        for (int o = 1; o < 4; ++o) if (lg[o] > gm) { gm = lg[o]; gi = o; }
        float den = 0.f;
#pragma unroll
        for (int o = 0; o < 4; ++o) den += __expf(lg[o] - gm);
        const float pg = 1.f / den;
        float le[8];
#pragma unroll
        for (int e = 0; e < 8; ++e) le[e] = dotw(4 + gi * 8 + e) + P.in[I_MBE][(layer * 4 + gi) * 8 + e];
        int e0 = 0; float v0 = le[0];
#pragma unroll
        for (int e = 1; e < 8; ++e) if (le[e] > v0) { v0 = le[e]; e0 = e; }
        int e1 = -1; float v1 = -3.0e38f;
#pragma unroll
        for (int e = 0; e < 8; ++e) if (e != e0 && le[e] > v1) { v1 = le[e]; e1 = e; }
        const float x1 = __expf(v1 - v0);
        const float w0 = pg / (1.f + x1), w1 = pg * x1 / (1.f + x1);
        if (lane == 0) {
            const int ge0 = gi * 8 + e0, ge1 = gi * 8 + e1;
            tok_e[row * 2] = ge0; tok_e[row * 2 + 1] = ge1; tok_w[row * 2] = w0; tok_w[row * 2 + 1] = w1;
            const int p0 = atomicAdd(&cnt[ge0], 1); list[(size_t)ge0 * T + p0] = row * 2;
            const int p1 = atomicAdd(&cnt[ge1], 1); list[(size_t)ge1 * T + p1] = row * 2 + 1;
        }
    }
}

DI int moe_find_tile(const int* cnt, int ti, int ctiles, int& e_out, int& rt_out, int& ct_out, int& ne_out) {
    int base = 0;
    for (int e = 0; e < 32; ++e) {
        const int n = cnt[e]; const int nt = ((n + 127) >> 7) * ctiles;
        if (ti < base + nt) { const int q = ti - base; e_out = e; rt_out = q / ctiles; ct_out = q % ctiles; ne_out = n; return 1; }
        base += nt;
    }
    return 0;
}
DI void ph_moe1(const Params& P, int layer, unsigned char* smem) {
    unsigned char* ws = P.ws;
    const int* cnt = (const int*)(ws + WS_CTL + CTL_CNT_OFF) + layer * 32;
    const int* list = (const int*)(ws + WS_LIST);
    const u16* hn = (const u16*)(ws + WS_HN); const u16* wgu = (const u16*)(ws + WS_WGU); u16* hid = (u16*)(ws + WS_HID);
    const int lane = opq_tid() & 63;
#ifdef DBG_SORTED_LISTS
    {
        const int* tok_e = (const int*)(ws + WS_TOKE); int* wl = (int*)(ws + WS_LIST);
        const int wave = opq_tid() >> 6;
        for (int e = wave; e < 32; e += NWAVE) {
            int base = 0;
            for (int i0 = 0; i0 < 2 * T; i0 += 64) {
                const int en = i0 + lane; const bool m = tok_e[en] == e;
                const unsigned long long bal = __ballot(m);
                if (m) wl[(size_t)e * T + base + __popcll(bal & ((1ull << lane) - 1ull))] = en;
                base += __popcll(bal);
            }
        }
        __syncthreads();
    }
#endif
    for (int ti = blockIdx.x;; ti += gridDim.x) {
        int e, rt, ct, ne;
        if (!moe_find_tile(cnt, ti, 4, e, rt, ct, ne)) break;
        const int* le = list + (size_t)e * T + rt * 128; const int nrow = min(128, ne - rt * 128);
        gemm_tile<4, 2, 1, 2>(smem, [&](int r) { return hn + (size_t)(le[min(r, nrow - 1)] >> 1) * 1024; },
            wgu + (size_t)e * 512 * 1024, 1024, ct * 128, 1024,
            [&](f32x16 (&acc)[1][2], int r0, int c0) {
                const int j = ct * 64 + (c0 >> 6) * 32 + (lane & 31);
#pragma unroll
                for (int i = 0; i < 16; ++i) {
                    const int rr = r0 + crow(i, lane >> 5);
                    if (rr < nrow) { const float gte = acc[0][0][i]; hid[(size_t)le[rr] * 256 + j] = f2bf(silu_f(gte) * acc[0][1][i]); }
                }
            });
    }
}
DI void ph_moe2(const Params& P, int layer, unsigned char* smem) {
    unsigned char* ws = P.ws;
    const int* cnt = (const int*)(ws + WS_CTL + CTL_CNT_OFF) + layer * 32;
    const int* list = (const int*)(ws + WS_LIST); const float* tok_w = (const float*)(ws + WS_TOKW);
    const u16* hid = (const u16*)(ws + WS_HID); const u16* wd = (const u16*)(ws + WS_WD); u16* yb = (u16*)(ws + WS_Y);
    const int lane = opq_tid() & 63;
    for (int ti = blockIdx.x;; ti += gridDim.x) {
        int e, rt, ct, ne;
        if (!moe_find_tile(cnt, ti, 8, e, rt, ct, ne)) break;
        const int* le = list + (size_t)e * T + rt * 128; const int nrow = min(128, ne - rt * 128);
        gemm_tile<2, 4, 2, 1>(smem, [&](int r) { return hid + (size_t)le[min(r, nrow - 1)] * 256; },
            wd + (size_t)e * 1024 * 256, 256, ct * 128, 256,
            [&](f32x16 (&acc)[2][1], int r0, int c0) {
                const int col = ct * 128 + c0 + (lane & 31);
#pragma unroll
                for (int mi = 0; mi < 2; ++mi)
#pragma unroll
                    for (int i = 0; i < 16; ++i) {
                        const int rr = r0 + mi * 32 + crow(i, lane >> 5);
                        if (rr < nrow) { const int en = le[rr]; yb[(size_t)en * 1024 + col] = f2bf(acc[mi][0][i] * tok_w[en]); }
                    }
            });
    }
}

DI void ph_final(const Params& P) {
    unsigned char* ws = P.ws;
#ifdef DBG_DUMPF_OFF
    {
        const float* src = (const float*)(ws + DBG_DUMPF_OFF);
#ifndef DBG_DUMPF_N
#define DBG_DUMPF_N ((size_t)NB * SEQ * D)
#endif
        for (size_t i = (size_t)blockIdx.x * NTHR + threadIdx.x; i < (size_t)NB * SEQ * D; i += (size_t)gridDim.x * NTHR) { float vv = (i < (size_t)(DBG_DUMPF_N)) ? src[i] : 0.f;
#ifdef DBG_AMP
            vv = vv * 1048576.f; vv = vv - floorf(vv);
#endif
            P.out[i] = vv; }
        return;
    }
#endif
#ifdef DBG_DUMP_OFF
    {
        const u16* src = (const u16*)(ws + DBG_DUMP_OFF);
#ifndef DBG_DUMP_N
#define DBG_DUMP_N ((size_t)NB * SEQ * D)
#endif
        for (size_t i = (size_t)blockIdx.x * NTHR + threadIdx.x; i < (size_t)NB * SEQ * D; i += (size_t)gridDim.x * NTHR) { float vv = (i < (size_t)(DBG_DUMP_N)) ? bf2f(src[i]) : 0.f;
#ifdef DBG_AMP
            vv = vv * 4096.f; vv = vv - floorf(vv);
#endif
            P.out[i] = vv; }
        return;
    }
#endif
    const int tid = opq_tid(), lane = tid & 63, wave = tid >> 6;
    const float* xbuf = (const float*)(ws + WS_X); const u16* yb = (const u16*)(ws + WS_Y); const float* mods = (const float*)(ws + WS_MODS);
    for (int lr = blockIdx.x * NWAVE + wave; lr < NB * SEQ; lr += gridDim.x * NWAVE) {
        const int b = lr / SEQ, l = lr % SEQ, row = b * LSEQ + CTX + l;
        const float* xr = xbuf + (size_t)row * 1024;
        const float* g2 = mods + ((size_t)(DEPTH - 1) * 3 + b) * 6144 + 5 * 1024;
        const u16* y0 = yb + (size_t)(2 * row) * 1024; const u16* y1 = y0 + 1024;
#pragma unroll
        for (int i = 0; i < 4; ++i) {
            float4 v = *(const float4*)(xr + i * 256 + lane * 4);
            const uint2 a = *(const uint2*)(y0 + i * 256 + lane * 4), c = *(const uint2*)(y1 + i * 256 + lane * 4);
            const float4 gg = *(const float4*)(g2 + i * 256 + lane * 4);
#ifndef DBG_STOP_L
            v.x += gg.x * (bflo(a.x) + bflo(c.x)); v.y += gg.y * (bfhi(a.x) + bfhi(c.x));
            v.z += gg.z * (bflo(a.y) + bflo(c.y)); v.w += gg.w * (bfhi(a.y) + bfhi(c.y));
#endif
            *(float4*)(P.out + (size_t)lr * 1024 + i * 256 + lane * 4) = v;
        }
    }
}

extern __shared__ __attribute__((aligned(16))) unsigned char g_smem[];
__global__ void __launch_bounds__(NTHR, 2) trunk_fwd(Params P) {
    unsigned char* smem = g_smem;
    volatile LAS unsigned* xbw = (volatile LAS unsigned*)(g_smem + LDS_BYTES);
    XcdBarrier bar; bar.bar = (unsigned*)(P.ws + WS_CTL); bar.x = 0; bar.st = xbw;
    if (P.use_bar) {
        if (threadIdx.x == 0) { xbw[0] = 0u; xbw[1] = 0u; xbw[2] = 0u; xbw[3] = 0u; }
        __syncthreads();
        bar = xcd_barrier_post((unsigned*)(P.ws + WS_CTL), xbw);
    }
#define GRID_BAR() do { if (P.use_bar) xcd_barrier(bar); } while (0)
#ifdef ONLY_PH
#define IN(k) ((k) == ONLY_PH && P.ph_lo <= (k) && (k) < P.ph_hi)
#else
#define IN(k) (P.ph_lo <= (k) && (k) < P.ph_hi)
#endif
    if (P.lay_lo == 0 && IN(0)) { ph_prologue(P, smem); GRID_BAR(); }
    for (int layer = P.lay_lo; layer < P.lay_hi; ++layer) {
        if (IN(1)) { ph_norm1(P, layer, smem); GRID_BAR(); }
        if (IN(2)) { ph_gemm_in(P, smem); GRID_BAR(); }
        if (IN(3)) { ph_prep(P, layer, smem); GRID_BAR(); }
        if (IN(4)) { ph_attn(P, layer, smem); GRID_BAR(); }
        if (IN(5)) { ph_ssm_out(P, layer, smem); GRID_BAR(); }
        if (IN(6)) { ph_gemm_out(P, layer, smem); GRID_BAR(); }
        if (IN(7)) { ph_norm2_route(P, layer, smem); GRID_BAR(); }
        if (IN(8)) { ph_moe1(P, layer, smem); GRID_BAR(); }
        if (IN(9)) { ph_moe2(P, layer, smem); GRID_BAR(); }
    }
    if (P.lay_hi == DEPTH && IN(10)) ph_final(P);
#undef IN
#undef GRID_BAR
}

#ifndef N_LAUNCH_MODE
#define N_LAUNCH_MODE 0
#endif
extern "C" void kernel_launch(void* const* d_in, const int* in_sizes, int n_in, void* d_out, int out_size, void* d_ws, size_t ws_size, hipStream_t stream) {
    static int grid = 0;
    constexpr int DYN_LDS = LDS_BYTES + 16;
    if (grid == 0) {
        if (n_in != 45 || out_size != NB * SEQ * D || ws_size < WS_END) {
            fprintf(stderr, "kernel_launch: unexpected shapes (n_in %d out %d ws %zu need %zu)\n", n_in, out_size, ws_size, (size_t)WS_END); grid = -1; return;
        }
        int dev = 0, cus = 0, per_cu = 0;
        hipGetDevice(&dev); hipDeviceGetAttribute(&cus, hipDeviceAttributeMultiprocessorCount, dev);
        hipFuncSetAttribute((const void*)trunk_fwd, hipFuncAttributeMaxDynamicSharedMemorySize, DYN_LDS);
        hipOccupancyMaxActiveBlocksPerMultiprocessor(&per_cu, (const void*)trunk_fwd, NTHR, DYN_LDS);
        (void)hipGetLastError();
        if (per_cu < 1) fprintf(stderr, "kernel_launch: occupancy query says %d blocks/CU\n", per_cu);
        grid = cus;
    }
    if (grid < 0) return;
    hipMemsetAsync((char*)d_ws + WS_CTL, 0, CTL_BYTES, stream);
    Params p; memset(&p, 0, sizeof(p));
    for (int i = 0; i < 45; ++i) p.in[i] = (const float*)d_in[i];
    p.out = (float*)d_out; p.ws = (unsigned char*)d_ws;
#if N_LAUNCH_MODE == 1
    p.lay_lo = 0; p.lay_hi = DEPTH; p.ph_lo = 0; p.ph_hi = 11; p.use_bar = 1;
    hipLaunchKernelGGL(trunk_fwd, dim3(grid), dim3(NTHR), DYN_LDS, stream, p);
#else
    p.use_bar = 0;
    p.lay_lo = 0; p.lay_hi = 0; p.ph_lo = 0; p.ph_hi = 1;
    hipLaunchKernelGGL(trunk_fwd, dim3(grid), dim3(NTHR), DYN_LDS, stream, p);
    for (int l = 0; l < DEPTH; ++l)
        for (int ph = 1; ph <= 9; ++ph) {
#ifdef DBG_STOP_L
            if (l > DBG_STOP_L || (l == DBG_STOP_L && ph > DBG_STOP_P)) continue;
#endif
            p.lay_lo = l; p.lay_hi = l + 1; p.ph_lo = ph; p.ph_hi = ph + 1;
            hipLaunchKernelGGL(trunk_fwd, dim3(grid), dim3(NTHR), DYN_LDS, stream, p);
        }
    p.lay_lo = DEPTH; p.lay_hi = DEPTH; p.ph_lo = 10; p.ph_hi = 11;
    hipLaunchKernelGGL(trunk_fwd, dim3(grid), dim3(NTHR), DYN_LDS, stream, p);
#endif
}
```

```cpp
#define N_LAUNCH_MODE 1
#include <hip/hip_runtime.h>
#include <cstdio>
#include <cstdint>
#include <cstring>

typedef unsigned short u16;
typedef __attribute__((ext_vector_type(8))) short bf16x8;
typedef __attribute__((ext_vector_type(16))) float f32x16;
typedef __bf16 bf2_t __attribute__((ext_vector_type(2)));
typedef float f2_t __attribute__((ext_vector_type(2)));
#define DI __device__ __forceinline__
#define MFMA32(a, b, c) __builtin_amdgcn_mfma_f32_32x32x16_bf16((a), (b), (c), 0, 0, 0)

constexpr int D = 1024, NB = 2, SEQ = 8192, CTX = 256, LSEQ = CTX + SEQ, T = NB * LSEQ, DEPTH = 4;
constexpr int NTHR = 512, NWAVE = 8;
constexpr int PC = 2432;
constexpr int IN_COLS = 2344;
constexpr int C_MQ = 0, C_MCKV = 384, C_MKR = 512, C_SZ = 544, C_SXBC = 800, C_SDT = 1312, C_S5U = 1320, C_DQ = 1576, C_DK = 1832, C_DV = 2088;
constexpr int NCH = LSEQ / 128;
constexpr float EPS = 1e-6f;
constexpr float LOG2E = 1.4426950408889634f;

constexpr size_t al256(size_t x) { return (x + 255) & ~(size_t)255; }
constexpr size_t WS_CTL = 0;
constexpr size_t CTL_CNT_OFF = 16384;
constexpr size_t CTL_BYTES = 32768;
constexpr size_t WS_MODS = WS_CTL + CTL_BYTES;
constexpr size_t WS_S5A = al256(WS_MODS + (size_t)DEPTH * 3 * 6144 * 4);
constexpr size_t WS_S5BT = al256(WS_S5A + (size_t)DEPTH * 2 * 16 * 64 * 2 * 4);
constexpr size_t WS_S5CT = al256(WS_S5BT + (size_t)DEPTH * 2 * 16 * 128 * 16 * 2);
constexpr size_t WS_X = al256(WS_S5CT + (size_t)DEPTH * 2 * 16 * 16 * 128 * 2);
constexpr size_t WS_HN = al256(WS_X + (size_t)T * D * 4);
constexpr size_t WS_P = al256(WS_HN + (size_t)T * D * 2);
constexpr size_t WS_QM = al256(WS_P + (size_t)T * PC * 2);
constexpr size_t WS_KM = al256(WS_QM + (size_t)NB * 4 * LSEQ * 96 * 2);
constexpr size_t WS_VTM = al256(WS_KM + (size_t)NB * 4 * LSEQ * 96 * 2);
constexpr size_t WS_QD = al256(WS_VTM + (size_t)NB * 4 * 64 * LSEQ * 2);
constexpr size_t WS_KD = al256(WS_QD + (size_t)NB * 4 * LSEQ * 64 * 2);
constexpr size_t WS_VTD = al256(WS_KD + (size_t)NB * 4 * LSEQ * 64 * 2);
constexpr size_t WS_CAT = al256(WS_VTD + (size_t)NB * 4 * 64 * LSEQ * 2);
constexpr size_t WS_SXS = al256(WS_CAT + (size_t)T * D * 2);
constexpr size_t WS_SB = al256(WS_SXS + (size_t)T * 256 * 2);
constexpr size_t WS_SC = al256(WS_SB + (size_t)T * 128 * 2);
constexpr size_t WS_SDT = al256(WS_SC + (size_t)T * 128 * 2);
constexpr size_t WS_SE = al256(WS_SDT + (size_t)T * 8 * 4);
constexpr size_t WS_SST = al256(WS_SE + (size_t)T * 8 * 4);
constexpr size_t WS_SCD = al256(WS_SST + (size_t)NB * 2 * NCH * 4 * 4096 * 4);
constexpr size_t WS_S5F = al256(WS_SCD + (size_t)NB * 2 * NCH * 4 * 4);
constexpr size_t WS_TOKE = al256(WS_S5F + (size_t)NB * 2 * NCH * 16 * 64 * 2 * 4);
constexpr size_t WS_TOKW = al256(WS_TOKE + (size_t)T * 2 * 4);
constexpr size_t WS_LIST = al256(WS_TOKW + (size_t)T * 2 * 4);
constexpr size_t WS_HID = al256(WS_LIST + (size_t)32 * T * 4);
constexpr size_t WS_Y = al256(WS_HID + (size_t)T * 2 * 256 * 2);
constexpr size_t WS_WIN = al256(WS_Y + (size_t)T * 2 * D * 2);
constexpr size_t WS_WOUT = al256(WS_WIN + (size_t)PC * D * 2);
constexpr size_t WS_WGU = al256(WS_WOUT + (size_t)D * D * 2);
constexpr size_t WS_WD = al256(WS_WGU + (size_t)32 * 512 * D * 2);
constexpr size_t WS_WGLU = al256(WS_WD + (size_t)32 * D * 256 * 2);
constexpr size_t WS_WKV = al256(WS_WGLU + (size_t)256 * 256 * 2);
constexpr size_t WS_END = al256(WS_WKV + (size_t)512 * 128 * 2);

constexpr int LDS_BYTES = 150 * 1024;

struct Params {
    const float* in[45];
    float* out;
    unsigned char* ws;
    int lay_lo, lay_hi, ph_lo, ph_hi;
    int use_bar, pad0;
};
enum { I_X = 0, I_C, I_CTX, I_CCTX, I_WADA, I_BADA, I_NORM1, I_NORM2, I_WIN, I_WOUT, I_MKVN, I_MWUK, I_MWUV, I_MQN, I_MKN,
       I_SCW, I_SCB, I_SALOG, I_SDTB, I_SD, I_SNORM, I_5LRE, I_5LIM, I_5LS, I_5BRE, I_5BIM, I_5CRE, I_5CIM, I_5D, I_5WGLU, I_5BGLU,
       I_DQN, I_DKN, I_DLQ1, I_DLK1, I_DLQ2, I_DLK2, I_DSUB, I_MWG, I_MBG, I_MWE, I_MBE, I_MWGATE, I_MWUP, I_MWDOWN };

DI int opq_tid() { int t = threadIdx.x; asm volatile("" : "+v"(t)); return t; }
DI float bf2f(u16 v) { return __uint_as_float(((unsigned)v) << 16); }
DI unsigned pack_bf2(float a, float b) { f2_t f = {a, b}; bf2_t r = __builtin_convertvector(f, bf2_t); return __builtin_bit_cast(unsigned, r); }
DI u16 f2bf(float a) { return (u16)(pack_bf2(a, 0.f) & 0xffffu); }
DI float bflo(unsigned w) { return __uint_as_float(w << 16); }
DI float bfhi(unsigned w) { return __uint_as_float(w & 0xffff0000u); }
DI int crow(int reg, int h) { return (reg & 3) + 8 * (reg >> 2) + 4 * h; }
DI int kpos(int t) { return (t & ~12) | ((t & 4) << 1) | ((t & 8) >> 1); }
DI float wave_sum(float v) {
#pragma unroll
    for (int o = 32; o >= 1; o >>= 1) v += __shfl_xor(v, o, 64);
    return v;
}
DI float silu_f(float x) { return x / (1.f + __expf(-x)); }
DI f32x16 zero16() { f32x16 z;
#pragma unroll
    for (int i = 0; i < 16; ++i) z[i] = 0.f; return z; }
DI bf16x8 ld_frag(const unsigned char* p) { return *(const bf16x8*)p; }
DI int chunk_at(int dir, int k) { return dir == 0 ? k : (k < 2 ? 1 - k : (NCH + 1) - k); }

#define XB_TMO      128
#define XB_XCNT(j)  (256  + 64 * (j))
#define XB_XSUB(j)  (1280 + 64 * (j))
#define XB_XGEN(j)  (2304 + 64 * (j))
#define XB_TOP      3328
#define XB_TOPGEN   3392
#define XCD_BAR_WORDS 3456
#define XB_SPIN_CAP (1u << 20)
#define LAS __attribute__((address_space(3)))

DI unsigned xb_ld(unsigned* p)              { return __hip_atomic_load(p, __ATOMIC_RELAXED, __HIP_MEMORY_SCOPE_AGENT); }
DI unsigned xb_add(unsigned* p, unsigned v) { return __hip_atomic_fetch_add(p, v, __ATOMIC_RELAXED, __HIP_MEMORY_SCOPE_AGENT); }
DI unsigned xb_xcc_id() { return (unsigned)__builtin_amdgcn_s_getreg((3 << 11) | 20) & 0xFu; }
#define XB_SPIN(cond, bar) do { unsigned _sp = 0; while (cond) { __builtin_amdgcn_s_sleep(1); \
    if ((++_sp & 255u) == 0u) { if (xb_ld(&(bar)[XB_TMO])) break; if (_sp > XB_SPIN_CAP) { atomicAdd(&(bar)[XB_TMO], 1u); break; } } } } while (0)

struct XcdBarrier { unsigned* bar; unsigned x; volatile LAS unsigned* st; };

DI XcdBarrier xcd_barrier_post(unsigned* bar, volatile LAS unsigned* st) {
    XcdBarrier b; b.bar = bar; b.x = xb_xcc_id(); b.st = st;
    if (threadIdx.x == 0) (void)xb_add(&bar[XB_XCNT(b.x)], 1u);
    return b;
}
DI void xcd_barrier_complete(unsigned* bar, unsigned x, unsigned& nloc, unsigned& nx) {
    const unsigned G = gridDim.x * gridDim.y * gridDim.z;
    unsigned sum, cnt, mine, sp = 0u;
    for (;;) {
        sum = 0u; cnt = 0u; mine = 0u;
#pragma unroll
        for (unsigned j = 0; j < 16; ++j) { const unsigned c = xb_ld(&bar[XB_XCNT(j)]); sum += c; cnt += (c > 0u) ? 1u : 0u; mine = (j == x) ? c : mine; }
        if (sum == G) break;
        __builtin_amdgcn_s_sleep(1);
        if ((++sp & 255u) == 0u) { if (xb_ld(&bar[XB_TMO])) break; if (sp > XB_SPIN_CAP) { atomicAdd(&bar[XB_TMO], 1u); break; } }
    }
    nloc = mine > 0u ? mine : 1u; nx = cnt > 0u ? cnt : 1u;
}
DI void xcd_barrier(const XcdBarrier& b) {
    asm volatile("s_waitcnt vmcnt(0)" ::: "memory");
    __syncthreads();
    if (threadIdx.x == 0) {
        unsigned* bar = b.bar;
        __builtin_amdgcn_s_waitcnt(0);
        unsigned nloc = b.st[0], nx = b.st[1];
        if (nloc == 0u) { xcd_barrier_complete(bar, b.x, nloc, nx); b.st[0] = nloc; b.st[1] = nx; }
        const unsigned old = xb_add(&bar[XB_XSUB(b.x)], 1u);
        const unsigned gen = old / nloc;
        if (old + 1u == (gen + 1u) * nloc) {
            __builtin_amdgcn_fence(__ATOMIC_RELEASE, "agent");
            asm volatile("s_waitcnt vmcnt(0)" ::: "memory");
            const unsigned og = xb_add(&bar[XB_TOP], 1u);
            const unsigned tg = og / nx;
            if (og + 1u == (tg + 1u) * nx) xb_add(&bar[XB_TOPGEN], 1u);
            else XB_SPIN(xb_ld(&bar[XB_TOPGEN]) == tg, bar);
            __builtin_amdgcn_fence(__ATOMIC_ACQUIRE, "agent");
            xb_add(&bar[XB_XGEN(b.x)], 1u);
            asm volatile("s_waitcnt vmcnt(0)" ::: "memory");
        } else {
            XB_SPIN(xb_ld(&bar[XB_XGEN(b.x)]) == gen, bar);
            __builtin_amdgcn_fence(__ATOMIC_ACQUIRE, "agent");
            asm volatile("s_waitcnt vmcnt(0)" ::: "memory");
        }
    }
    __syncthreads();
}

constexpr int LDT = 144;
template <int WGM, int WGN, int WM, int WN, class ARow, class Epi>
DI void gemm_tile(unsigned char* smem, ARow arow, const u16* __restrict__ Bt, int ldb, int n0, int K, Epi epi) {
    constexpr int BM = WGM * WM * 32, BN = WGN * WN * 32;
    constexpr int A_BYTES = BM * LDT, B_BYTES = BN * LDT, STAGE = A_BYTES + B_BYTES;
    constexpr int NA = BM * 8 / NTHR, NBc = BN * 8 / NTHR;
    static_assert(2 * STAGE <= LDS_BYTES, "gemm tile LDS");
    const int tid = opq_tid(), lane = tid & 63, wave = tid >> 6;
    const int wr = wave / WGN, wc = wave % WGN;
    const int lr = lane & 31, lh = lane >> 5;
    const uint4* ap[NA]; const uint4* bp[NBc];
#pragma unroll
    for (int i = 0; i < NA; ++i) ap[i] = (const uint4*)arow((tid >> 3) + 64 * i) + (tid & 7);
#pragma unroll
    for (int i = 0; i < NBc; ++i) bp[i] = (const uint4*)(Bt + (size_t)(n0 + (tid >> 3) + 64 * i) * ldb) + (tid & 7);
    const int woff = (tid >> 3) * LDT + (tid & 7) * 16;
    uint4 ra[NA], rb[NBc];
#pragma unroll
    for (int i = 0; i < NA; ++i) ra[i] = ap[i][0];
#pragma unroll
    for (int i = 0; i < NBc; ++i) rb[i] = bp[i][0];
#pragma unroll
    for (int i = 0; i < NA; ++i) *(uint4*)(smem + woff + i * 64 * LDT) = ra[i];
#pragma unroll
    for (int i = 0; i < NBc; ++i) *(uint4*)(smem + A_BYTES + woff + i * 64 * LDT) = rb[i];
    __syncthreads();
    f32x16 acc[WM][WN];
#pragma unroll
    for (int mi = 0; mi < WM; ++mi)
#pragma unroll
        for (int ni = 0; ni < WN; ++ni) acc[mi][ni] = zero16();
    const int nk = K / 64;
    const int a_rd = (wr * WM * 32 + lr) * LDT + lh * 16;
    const int b_rd = A_BYTES + (wc * WN * 32 + lr) * LDT + lh * 16;
    for (int kt = 0; kt < nk; ++kt) {
        const unsigned char* st = smem + (kt & 1) * STAGE;
        if (kt + 1 < nk) {
#pragma unroll
            for (int i = 0; i < NA; ++i) ra[i] = ap[i][(kt + 1) * 8];
#pragma unroll
            for (int i = 0; i < NBc; ++i) rb[i] = bp[i][(kt + 1) * 8];
        }
#pragma unroll
        for (int s = 0; s < 4; ++s) {
            bf16x8 a[WM], b[WN];
#pragma unroll
            for (int mi = 0; mi < WM; ++mi) a[mi] = ld_frag(st + a_rd + mi * 32 * LDT + s * 32);
#pragma unroll
            for (int ni = 0; ni < WN; ++ni) b[ni] = ld_frag(st + b_rd + ni * 32 * LDT + s * 32);
#pragma unroll
            for (int mi = 0; mi < WM; ++mi)
#pragma unroll
                for (int ni = 0; ni < WN; ++ni) acc[mi][ni] = MFMA32(a[mi], b[ni], acc[mi][ni]);
        }
        if (kt + 1 < nk) {
            unsigned char* sn = smem + ((kt + 1) & 1) * STAGE;
#pragma unroll
            for (int i = 0; i < NA; ++i) *(uint4*)(sn + woff + i * 64 * LDT) = ra[i];
#pragma unroll
            for (int i = 0; i < NBc; ++i) *(uint4*)(sn + A_BYTES + woff + i * 64 * LDT) = rb[i];
        }
        __syncthreads();
    }
    epi(acc, wr * WM * 32, wc * WN * 32);
}

DI void ph_prologue(const Params& P, unsigned char* smem) {
    unsigned char* ws = P.ws;
    const int tid = opq_tid();
    const size_t gtid = (size_t)blockIdx.x * NTHR + tid, gstr = (size_t)gridDim.x * NTHR;
    {
        float4* xb = (float4*)(ws + WS_X);
        const float4* xin = (const float4*)P.in[I_X]; const float4* cin = (const float4*)P.in[I_CTX];
        for (size_t i = gtid; i < (size_t)T * 256; i += gstr) {
            const int row = (int)(i >> 8), c4 = (int)(i & 255);
            const int b = row / LSEQ, u = row % LSEQ;
            xb[i] = (u < CTX) ? cin[((size_t)(b * CTX + u)) * 256 + c4] : xin[((size_t)(b * SEQ + u - CTX)) * 256 + c4];
        }
    }
    {
        float* sl = (float*)smem;
        float* red = sl + 3072;
        for (int i = tid; i < 3072; i += NTHR) {
            const int w = i >> 10, k = i & 1023;
            const float v = (w < 2) ? P.in[I_C][w * 1024 + k] : P.in[I_CCTX][k];
            sl[i] = v / (1.f + expf(-v));
        }
        __syncthreads();
        float* mods = (float*)(ws + WS_MODS);
        const int cg = tid & 15, ks = tid >> 4;
        for (int item = blockIdx.x; item < DEPTH * 96; item += gridDim.x) {
            const int l = item / 96, cb = item % 96;
            const float* wp = P.in[I_WADA] + ((size_t)l * 1024 + ks * 32) * 6144 + cb * 64 + cg * 4;
            float acc[3][4];
#pragma unroll
            for (int w = 0; w < 3; ++w)
#pragma unroll
                for (int j = 0; j < 4; ++j) acc[w][j] = 0.f;
#pragma unroll 8
            for (int kk = 0; kk < 32; ++kk) {
                const float4 wv = *(const float4*)(wp + (size_t)kk * 6144);
                const int k = ks * 32 + kk;
#pragma unroll
                for (int w = 0; w < 3; ++w) {
                    const float s = sl[w * 1024 + k];
                    acc[w][0] += s * wv.x; acc[w][1] += s * wv.y; acc[w][2] += s * wv.z; acc[w][3] += s * wv.w;
                }
            }
#pragma unroll
            for (int w = 0; w < 3; ++w)
#pragma unroll
                for (int j = 0; j < 4; ++j) red[(ks * 3 + w) * 64 + cg * 4 + j] = acc[w][j];
            __syncthreads();
            if (tid < 192) {
                const int w = tid >> 6, j = tid & 63;
                float s = P.in[I_BADA][l * 6144 + cb * 64 + j];
                for (int q = 0; q < 32; ++q) s += red[(q * 3 + w) * 64 + j];
                mods[((size_t)l * 3 + w) * 6144 + cb * 64 + j] = s;
            }
            __syncthreads();
        }
    }
    {
        float* s5a = (float*)(ws + WS_S5A); u16* bt = (u16*)(ws + WS_S5BT); u16* ct = (u16*)(ws + WS_S5CT);
        for (size_t idx = gtid; idx < (size_t)DEPTH * 2 * 16 * 64; idx += gstr) {
            const int p = (int)(idx & 63), g = (int)((idx >> 6) & 15), d = (int)((idx >> 10) & 1), l = (int)(idx >> 11);
            const float lr = P.in[I_5LRE][idx], li = P.in[I_5LIM][idx];
            const float step = expf(P.in[I_5LS][(l * 2 + d) * 16 + g]);
            const float er = expf(lr * step);
            const float ar = er * cosf(li * step), ai = er * sinf(li * step);
            const float nr = ar - 1.f, ni = ai, den = lr * lr + li * li;
            const float fr = (nr * lr + ni * li) / den, fi = (ni * lr - nr * li) / den;
            s5a[idx * 2] = ar; s5a[idx * 2 + 1] = ai;
            const size_t ldg = (size_t)(l * 2 + d) * 16 + g;
            const float* bre = P.in[I_5BRE] + (((size_t)l * 16 + g) * 64 + p) * 16;
            const float* bim = P.in[I_5BIM] + (((size_t)l * 16 + g) * 64 + p) * 16;
            for (int j = 0; j < 16; ++j) {
                const float br = fr * bre[j] - fi * bim[j], bi = fr * bim[j] + fi * bre[j];
                bt[(ldg * 128 + p) * 16 + j] = f2bf(br);
                bt[(ldg * 128 + 64 + p) * 16 + j] = f2bf(bi);
            }
            for (int jo = 0; jo < 16; ++jo) {
                const float cre = P.in[I_5CRE][(ldg * 16 + jo) * 64 + p], cim = P.in[I_5CIM][(ldg * 16 + jo) * 64 + p];
                ct[(ldg * 16 + jo) * 128 + 2 * p] = f2bf(cre);
                ct[(ldg * 16 + jo) * 128 + 2 * p + 1] = f2bf(-cim);
            }
        }
    }
}

DI void conv_tile64(float* tile, const float* __restrict__ src, int sstride, int R0, int C0, int Cvalid,
                    u16* __restrict__ dst, int dstride, int drow_base, int drow_hi) {
    const int tid = opq_tid();
#pragma unroll
    for (int it = 0; it < 2; ++it) {
        const int i = (tid >> 4) + 32 * it, j4 = (tid & 15) * 4;
        float4 v = make_float4(0.f, 0.f, 0.f, 0.f);
        if (C0 + j4 < Cvalid) v = *(const float4*)(src + (size_t)(R0 + i) * sstride + C0 + j4);
        float* tp = tile + i * 65 + j4;
        tp[0] = v.x; tp[1] = v.y; tp[2] = v.z; tp[3] = v.w;
    }
    __syncthreads();
    {
        const int j = tid >> 3, i8 = (tid & 7) * 8;
        uint4 o;
        o.x = pack_bf2(tile[(i8 + 0) * 65 + j], tile[(i8 + 1) * 65 + j]);
        o.y = pack_bf2(tile[(i8 + 2) * 65 + j], tile[(i8 + 3) * 65 + j]);
        o.z = pack_bf2(tile[(i8 + 4) * 65 + j], tile[(i8 + 5) * 65 + j]);
        o.w = pack_bf2(tile[(i8 + 6) * 65 + j], tile[(i8 + 7) * 65 + j]);
        const int drow = drow_base + (j >> 5) * drow_hi + (j & 31);
        *(uint4*)(dst + (size_t)drow * dstride + R0 + i8) = o;
    }
    __syncthreads();
}

DI void ph_norm1(const Params& P, int layer, unsigned char* smem) {
    unsigned char* ws = P.ws;
    const int tid = opq_tid(), lane = tid & 63, wave = tid >> 6;
    {
        float* xbuf = (float*)(ws + WS_X); u16* hn = (u16*)(ws + WS_HN); const u16* yb = (const u16*)(ws + WS_Y);
        const float* mods = (const float*)(ws + WS_MODS);
        const float* g1 = P.in[I_NORM1] + layer * 1024;
        float4 gv[4];
#pragma unroll
        for (int i = 0; i < 4; ++i) gv[i] = *(const float4*)(g1 + i * 256 + lane * 4);
        for (int row = blockIdx.x * NWAVE + wave; row < T; row += gridDim.x * NWAVE) {
            const int b = row / LSEQ, u = row % LSEQ, which = (u < CTX) ? 2 : b;
            float* xr = xbuf + (size_t)row * 1024;
            float4 v[4];
#pragma unroll
            for (int i = 0; i < 4; ++i) v[i] = *(const float4*)(xr + i * 256 + lane * 4);
            if (layer > 0) {
                const float* g2 = mods + ((size_t)(layer - 1) * 3 + which) * 6144 + 5 * 1024;
                const u16* y0 = yb + (size_t)(2 * row) * 1024; const u16* y1 = y0 + 1024;
#pragma unroll
                for (int i = 0; i < 4; ++i) {
                    const uint2 a = *(const uint2*)(y0 + i * 256 + lane * 4), c = *(const uint2*)(y1 + i * 256 + lane * 4);
                    const float4 gg = *(const float4*)(g2 + i * 256 + lane * 4);
                    v[i].x += gg.x * (bflo(a.x) + bflo(c.x)); v[i].y += gg.y * (bfhi(a.x) + bfhi(c.x));
                    v[i].z += gg.z * (bflo(a.y) + bflo(c.y)); v[i].w += gg.w * (bfhi(a.y) + bfhi(c.y));
                    *(float4*)(xr + i * 256 + lane * 4) = v[i];
                }
            }
            float ss = 0.f;
#pragma unroll
            for (int i = 0; i < 4; ++i) ss += v[i].x * v[i].x + v[i].y * v[i].y + v[i].z * v[i].z + v[i].w * v[i].w;
            ss = wave_sum(ss);
            const float rstd = rsqrtf(ss * (1.f / 1024.f) + EPS);
            const float* sh = mods + ((size_t)layer * 3 + which) * 6144; const float* sc = sh + 1024;
#pragma unroll
            for (int i = 0; i < 4; ++i) {
                const float4 s4 = *(const float4*)(sh + i * 256 + lane * 4), c4 = *(const float4*)(sc + i * 256 + lane * 4);
                uint2 o;
                o.x = pack_bf2(v[i].x * rstd * gv[i].x * (1.f + c4.x) + s4.x, v[i].y * rstd * gv[i].y * (1.f + c4.y) + s4.y);
                o.y = pack_bf2(v[i].z * rstd * gv[i].z * (1.f + c4.z) + s4.z, v[i].w * rstd * gv[i].w * (1.f + c4.w) + s4.w);
                *(uint2*)(hn + (size_t)row * 1024 + i * 256 + lane * 4) = o;
            }
        }
    }
    {
        float* tile = (float*)smem;
        constexpr int J0 = 16 * 38, J1 = J0 + 256, J2 = J1 + 2048, J3 = J2 + 2048, J4 = J3 + 2048, J5 = J4 + 16, J6 = J5 + 8, J7 = J6 + 8;
        for (int it = blockIdx.x; it < J7; it += gridDim.x) {
            if (it < J0) {
                const int rt = it / 38, ctile = it % 38;
                conv_tile64(tile, P.in[I_WIN] + (size_t)layer * 1024 * IN_COLS, IN_COLS, rt * 64, ctile * 64, IN_COLS, (u16*)(ws + WS_WIN), 1024, ctile * 64, 32);
            } else if (it < J1) {
                const int q = it - J0, rt = q >> 4, ctile = q & 15;
                conv_tile64(tile, P.in[I_WOUT] + (size_t)layer * 1024 * 1024, 1024, rt * 64, ctile * 64, 1024, (u16*)(ws + WS_WOUT), 1024, ctile * 64, 32);
            } else if (it < J3) {
                const int up = it >= J2; const int q = it - (up ? J2 : J1);
                const int e = q >> 6, rt = (q >> 2) & 15, ctile = q & 3;
                const float* src = P.in[up ? I_MWUP : I_MWGATE] + ((size_t)layer * 32 + e) * 1024 * 256;
                conv_tile64(tile, src, 256, rt * 64, ctile * 64, 256, (u16*)(ws + WS_WGU) + (size_t)e * 512 * 1024, 1024, ctile * 128 + up * 32, 64);
            } else if (it < J4) {
                const int q = it - J3, e = q >> 6, rt = (q >> 4) & 3, ctile = q & 15;
                const float* src = P.in[I_MWDOWN] + ((size_t)layer * 32 + e) * 256 * 1024;
                conv_tile64(tile, src, 1024, rt * 64, ctile * 64, 1024, (u16*)(ws + WS_WD) + (size_t)e * 1024 * 256, 256, ctile * 64, 32);
            } else if (it < J5) {
                const int q = it - J4, rt = q >> 2, ctile = q & 3;
                conv_tile64(tile, P.in[I_5WGLU] + (size_t)layer * 256 * 256, 256, rt * 64, ctile * 64, 256, (u16*)(ws + WS_WGLU), 256, ctile * 64, 32);
            } else {
                const int uv = it >= J6; const int q = it - (uv ? J6 : J5), rt = q >> 2, ctile = q & 3;
                const float* src = P.in[uv ? I_MWUV : I_MWUK] + (size_t)layer * 128 * 256;
                conv_tile64(tile, src, 256, rt * 64, ctile * 64, 256, (u16*)(ws + WS_WKV), 128, uv * 256 + ctile * 64, 32);
            }
        }
    }
}

DI void ph_gemm_in(const Params& P, unsigned char* smem) {
    unsigned char* ws = P.ws;
    const u16* hn = (const u16*)(ws + WS_HN); const u16* wt = (const u16*)(ws + WS_WIN); u16* pb = (u16*)(ws + WS_P);
    const int lane = opq_tid() & 63;
    constexpr int NT = PC / 128, MT = T / 256;
    for (int tile = blockIdx.x; tile < MT * NT; tile += gridDim.x) {
        const int mt = tile / NT, nt = tile % NT;
        const int m0 = mt * 256, n0 = nt * 128;
        gemm_tile<4, 2, 2, 2>(smem, [&](int r) { return hn + (size_t)(m0 + r) * 1024; }, wt, 1024, n0, 1024,
            [&](f32x16 (&acc)[2][2], int r0, int c0) {
#pragma unroll
                for (int mi = 0; mi < 2; ++mi)
#pragma unroll
                    for (int ni = 0; ni < 2; ++ni) {
                        u16* o = pb + (size_t)(m0 + r0 + mi * 32) * PC + n0 + c0 + ni * 32 + (lane & 31);
#pragma unroll
                        for (int i = 0; i < 16; ++i) o[(size_t)crow(i, lane >> 5) * PC] = f2bf(acc[mi][ni][i]);
                    }
            });
    }
}

constexpr int LDS_TAB = 136 * 1024;
constexpr int LDS_GAIN = LDS_TAB + 8192;
DI float fma_asm(float a, float b, float c) { float d; asm("v_fma_f32 %0, %1, %2, %3" : "=v"(d) : "v"(a), "v"(b), "v"(c)); return d; }
DI void wave_lds_fence() { asm volatile("s_waitcnt lgkmcnt(0)" ::: "memory"); __builtin_amdgcn_wave_barrier(); }

DI void unpack8(const uint4& r, float* x) {
    x[0] = bflo(r.x); x[1] = bfhi(r.x); x[2] = bflo(r.y); x[3] = bfhi(r.y); x[4] = bflo(r.z); x[5] = bfhi(r.z); x[6] = bflo(r.w); x[7] = bfhi(r.w);
}
DI uint4 pack8(const float* x) { uint4 o; o.x = pack_bf2(x[0], x[1]); o.y = pack_bf2(x[2], x[3]); o.z = pack_bf2(x[4], x[5]); o.w = pack_bf2(x[6], x[7]); return o; }
DI void rope32(float* t, const float* cs, int gr, int gc) {
#pragma unroll
    for (int i = 0; i < 8; ++i) {
        const float c = cs[(gr * 8 + i) * 2], s = cs[(gr * 8 + i) * 2 + 1];
        const float a = t[i], b = t[8 + i]; t[i] = a * c - b * s; t[8 + i] = a * s + b * c;
        const float c2 = cs[(gc * 8 + i) * 2], s2 = cs[(gc * 8 + i) * 2 + 1];
        const float a2 = t[16 + i], b2 = t[24 + i]; t[16 + i] = a2 * c2 - b2 * s2; t[24 + i] = a2 * s2 + b2 * c2;
    }
}
DI void rope16(float* t, const float* cs, int pos) {
#pragma unroll
    for (int i = 0; i < 8; ++i) {
        const float c = cs[(pos * 8 + i) * 2], s = cs[(pos * 8 + i) * 2 + 1];
        const float a = t[i], b = t[8 + i]; t[i] = a * c - b * s; t[8 + i] = a * s + b * c;
    }
}

DI void mla_prep_item(const Params& P, int item, unsigned char* smem) {
    unsigned char* ws = P.ws;
    const float* cs = (const float*)(smem + LDS_TAB); const float* gn = (const float*)(smem + LDS_GAIN);
    const float* qn = gn; const float* kn = gn + 96; const float* kvn = gn + 192;
    const int tid = opq_tid(), lane = tid & 63, wave = tid >> 6, r = lane & 31, hh = lane >> 5;
    const int row = item * 256 + wave * 32 + r;
    const int b = row / LSEQ, u = row % LSEQ; const bool lat = u >= CTX; const int l = lat ? u - CTX : 0; const int gr = l >> 6, gc = l & 63;
    const u16* pr = (const u16*)(ws + WS_P) + (size_t)row * PC;
    u16* Qm = (u16*)(ws + WS_QM); u16* Km = (u16*)(ws + WS_KM); u16* Vt = (u16*)(ws + WS_VTM);
    const u16* wkv = (const u16*)(ws + WS_WKV);
    const float qscale = 1.472444460e-01f;
#pragma unroll 1
    for (int hq = 0; hq < 2; ++hq) {
        const int head = 2 * hh + hq;
        uint4 raw[12]; float ss = 0.f;
#pragma unroll
        for (int i = 0; i < 12; ++i) { raw[i] = *(const uint4*)(pr + C_MQ + head * 96 + i * 8); float x[8]; unpack8(raw[i], x);
#pragma unroll
            for (int j = 0; j < 8; ++j) ss += x[j] * x[j]; }
        const float rstd = rsqrtf(ss * (1.f / 96.f) + EPS);
        u16* qo = Qm + ((size_t)(b * 4 + head) * LSEQ + u) * 96;
#pragma unroll
        for (int i = 0; i < 8; ++i) { float x[8]; unpack8(raw[i], x);
#pragma unroll
            for (int j = 0; j < 8; ++j) x[j] = x[j] * rstd * qn[i * 8 + j] * qscale;
            *(uint4*)(qo + i * 8) = pack8(x); }
        float t[32];
#pragma unroll
        for (int i = 0; i < 4; ++i) { float x[8]; unpack8(raw[8 + i], x);
#pragma unroll
            for (int j = 0; j < 8; ++j) t[i * 8 + j] = x[j] * rstd * qn[64 + i * 8 + j]; }
        if (lat) rope32(t, cs, gr, gc);
#pragma unroll
        for (int i = 0; i < 32; ++i) t[i] *= qscale;
#pragma unroll
        for (int i = 0; i < 4; ++i) *(uint4*)(qo + 64 + i * 8) = pack8(t + i * 8);
    }
    bf16x8 cf[8];
    {
        uint4 raw[8]; float ss = 0.f;
#pragma unroll
        for (int s = 0; s < 8; ++s) { raw[s] = *(const uint4*)(pr + C_MCKV + 16 * s + 8 * hh); float x[8]; unpack8(raw[s], x);
#pragma unroll
            for (int j = 0; j < 8; ++j) ss += x[j] * x[j]; }
        ss += __shfl_xor(ss, 32, 64);
        const float rstd = rsqrtf(ss * (1.f / 128.f) + EPS);
#pragma unroll
        for (int s = 0; s < 8; ++s) { float x[8]; unpack8(raw[s], x);
#pragma unroll
            for (int j = 0; j < 8; ++j) x[j] = x[j] * rstd * kvn[16 * s + 8 * hh + j];
            const uint4 pk = pack8(x); cf[s] = __builtin_bit_cast(bf16x8, pk); }
    }
    float kr[16]; float ssr = 0.f;
    {
        const uint4 r0 = *(const uint4*)(pr + C_MKR + 16 * hh), r1 = *(const uint4*)(pr + C_MKR + 16 * hh + 8);
        unpack8(r0, kr); unpack8(r1, kr + 8);
#pragma unroll
        for (int j = 0; j < 16; ++j) ssr += kr[j] * kr[j];
        ssr += __shfl_xor(ssr, 32, 64);
    }
#pragma unroll 1
    for (int hd = 0; hd < 4; ++hd) {
        f32x16 k0 = zero16(), k1 = zero16();
#pragma unroll
        for (int s = 0; s < 8; ++s) {
            const bf16x8 a0 = *(const bf16x8*)(wkv + (size_t)(hd * 64 + r) * 128 + 16 * s + 8 * hh);
            const bf16x8 a1 = *(const bf16x8*)(wkv + (size_t)(hd * 64 + 32 + r) * 128 + 16 * s + 8 * hh);
            k0 = MFMA32(a0, cf[s], k0); k1 = MFMA32(a1, cf[s], k1);
        }
        float ssk = 0.f;
#pragma unroll
        for (int i = 0; i < 16; ++i) ssk += k0[i] * k0[i] + k1[i] * k1[i];
        ssk += __shfl_xor(ssk, 32, 64);
        const float rstd = rsqrtf((ssk + ssr) * (1.f / 96.f) + EPS);
        u16* ko = Km + ((size_t)(b * 4 + hd) * LSEQ + u) * 96;
#pragma unroll
        for (int q4 = 0; q4 < 4; ++q4) {
            const int d0 = 8 * q4 + 4 * hh;
            uint2 o;
            o.x = pack_bf2(k0[4 * q4] * rstd * kn[d0], k0[4 * q4 + 1] * rstd * kn[d0 + 1]);
            o.y = pack_bf2(k0[4 * q4 + 2] * rstd * kn[d0 + 2], k0[4 * q4 + 3] * rstd * kn[d0 + 3]);
            *(uint2*)(ko + d0) = o;
            o.x = pack_bf2(k1[4 * q4] * rstd * kn[32 + d0], k1[4 * q4 + 1] * rstd * kn[32 + d0 + 1]);
            o.y = pack_bf2(k1[4 * q4 + 2] * rstd * kn[32 + d0 + 2], k1[4 * q4 + 3] * rstd * kn[32 + d0 + 3]);
            *(uint2*)(ko + 32 + d0) = o;
        }
        {
            float t[16];
#pragma unroll
            for (int j = 0; j < 16; ++j) t[j] = kr[j] * rstd * kn[64 + 16 * hh + j];
            if (lat) rope16(t, cs, hh ? gc : gr);
            *(uint4*)(ko + 64 + 16 * hh) = pack8(t); *(uint4*)(ko + 64 + 16 * hh + 8) = pack8(t + 8);
        }
        f32x16 v0 = zero16(), v1 = zero16();
#pragma unroll
        for (int s = 0; s < 8; ++s) {
            const bf16x8 a2 = *(const bf16x8*)(wkv + (size_t)(256 + hd * 64 + r) * 128 + 16 * s + 8 * hh);
            const bf16x8 a3 = *(const bf16x8*)(wkv + (size_t)(256 + hd * 64 + 32 + r) * 128 + 16 * s + 8 * hh);
            v0 = MFMA32(a2, cf[s], v0); v1 = MFMA32(a3, cf[s], v1);
        }
        u16* vo = Vt + ((size_t)(b * 4 + hd) * 64) * LSEQ + kpos(u);
#pragma unroll
        for (int i = 0; i < 16; ++i) {
            vo[(size_t)crow(i, hh) * LSEQ] = f2bf(v0[i]);
            vo[(size_t)(32 + crow(i, hh)) * LSEQ] = f2bf(v1[i]);
        }
    }
}

DI void diff_prep_item(const Params& P, int item, unsigned char* smem) {
    unsigned char* ws = P.ws;
    const float* cs = (const float*)(smem + LDS_TAB); const float* gn = (const float*)(smem + LDS_GAIN);
    const int tid = opq_tid(), tokl = tid & 255, part = tid >> 8;
    const int row = item * 256 + tokl;
    const int b = row / LSEQ, u = row % LSEQ; const bool lat = u >= CTX; const int l = lat ? u - CTX : 0; const int gr = l >> 6, gc = l & 63;
    const u16* pr = (const u16*)(ws + WS_P) + (size_t)row * PC;
    {
        const float* g = gn + 320 + part * 32;
        const float scale = part ? 1.f : 2.550348616e-01f;
        const u16* src = pr + (part ? C_DK : C_DQ);
        u16* dst = (u16*)(ws + (part ? WS_KD : WS_QD));
#pragma unroll 1
        for (int head = 0; head < 8; ++head) {
            float t[32]; float ss = 0.f;
#pragma unroll
            for (int i = 0; i < 4; ++i) { const uint4 rr = *(const uint4*)(src + head * 32 + i * 8); unpack8(rr, t + i * 8); }
#pragma unroll
            for (int i = 0; i < 32; ++i) ss += t[i] * t[i];
            const float rstd = rsqrtf(ss * (1.f / 32.f) + EPS);
#pragma unroll
            for (int i = 0; i < 32; ++i) t[i] = t[i] * rstd * g[i];
            if (lat) rope32(t, cs, gr, gc);
#pragma unroll
            for (int i = 0; i < 32; ++i) t[i] *= scale;
            u16* o = dst + ((size_t)(b * 4 + (head >> 1)) * LSEQ + u) * 64 + (head & 1) * 32;
#pragma unroll
            for (int i = 0; i < 4; ++i) *(uint4*)(o + i * 8) = pack8(t + i * 8);
        }
    }
    {
        u16* vt = (u16*)(ws + WS_VTD);
        const int half = part;
#pragma unroll 4
        for (int c8 = 0; c8 < 16; ++c8) {
            const uint4 rr = *(const uint4*)(pr + C_DV + half * 128 + c8 * 8);
            const unsigned wds[4] = {rr.x, rr.y, rr.z, rr.w};
#pragma unroll
            for (int j = 0; j < 8; ++j) {
                const int dim = half * 128 + c8 * 8 + j, hv = dim >> 6, d = dim & 63;
                const u16 val = (u16)((j & 1) ? (wds[j >> 1] >> 16) : (wds[j >> 1] & 0xffffu));
                vt[((size_t)(b * 4 + hv) * 64 + d) * LSEQ + kpos(u)] = val;
            }
        }
    }
}

constexpr int SSD_XT = 0, SSD_BT = 69632, SSD_DTV = 104448, SSD_EV = 108544, SSD_WV = 112640;
DI void ssd_chunk_item(const Params& P, int layer, int ci, unsigned char* smem) {
    unsigned char* ws = P.ws;
    const int tid = opq_tid(), lane = tid & 63, wave = tid >> 6, r = lane & 31, hh = lane >> 5;
    const int b = ci / NCH, c = ci % NCH, u0 = c * 128, row0 = b * LSEQ + u0;
    const u16* pb = (const u16*)(ws + WS_P);
    u16* XT = (u16*)(smem + SSD_XT); u16* BT = (u16*)(smem + SSD_BT);
    float* dtv = (float*)(smem + SSD_DTV); float* Ev = (float*)(smem + SSD_EV); float* wvp = (float*)(smem + SSD_WV);
    {
        const int dir = wave >> 2, h = wave & 3;
        const float a = -expf(P.in[I_SALOG][layer * 8 + dir * 4 + h]);
        const float bias = P.in[I_SDTB][layer * 8 + dir * 4 + h];
        const int t0 = lane, t1 = lane + 64;
        const float r0 = bf2f(pb[(size_t)(row0 + t0) * PC + C_SDT + dir * 4 + h]) + bias;
        const float r1 = bf2f(pb[(size_t)(row0 + t1) * PC + C_SDT + dir * 4 + h]) + bias;
        const float dt0 = r0 > 20.f ? r0 : log1pf(expf(r0)), dt1 = r1 > 20.f ? r1 : log1pf(expf(r1));
        const float dA0 = dt0 * a, dA1 = dt1 * a;
        float s0 = dA0, s1 = dA1;
#pragma unroll
        for (int o = 1; o < 64; o <<= 1) { const float n0 = __shfl_up(s0, o, 64), n1 = __shfl_up(s1, o, 64); if (lane >= o) { s0 += n0; s1 += n1; } }
        const float tot0 = __shfl(s0, 63, 64); s1 += tot0;
        const float total = __shfl(s1, 63, 64);
        const float E0 = dir ? (total - s0 + dA0) : s0, E1 = dir ? (total - s1 + dA1) : s1;
        dtv[wave * 128 + t0] = dt0; dtv[wave * 128 + t1] = dt1;
        Ev[wave * 128 + t0] = E0; Ev[wave * 128 + t1] = E1;
        wvp[wave * 128 + kpos(t0)] = expf(total - E0) * dt0; wvp[wave * 128 + kpos(t1)] = expf(total - E1) * dt1;
        float* gdt = (float*)(ws + WS_SDT); float* ge = (float*)(ws + WS_SE);
        gdt[(size_t)(row0 + t0) * 8 + wave] = dt0; gdt[(size_t)(row0 + t1) * 8 + wave] = dt1;
        ge[(size_t)(row0 + t0) * 8 + wave] = E0; ge[(size_t)(row0 + t1) * 8 + wave] = E1;
        if (lane == 0) ((float*)(ws + WS_SCD))[((b * 2 + dir) * NCH + c) * 4 + h] = expf(total);
    }
    {
        const int cidx = tid;
        const float* cw = P.in[I_SCW] + (size_t)layer * 3 * 512;
        const float w0 = cw[cidx], w1 = cw[512 + cidx], w2 = cw[1024 + cidx], cb = P.in[I_SCB][layer * 512 + cidx];
        const u16* col = pb + (size_t)row0 * PC + C_SXBC + cidx;
        const bool lv = (u0 != 0) && (u0 != CTX), rv = (u0 + 128 != CTX) && (u0 + 128 != LSEQ);
        float prev = lv ? bf2f(col[-(ptrdiff_t)PC]) : 0.f, cur = bf2f(col[0]);
        u16* gx = (u16*)(ws + WS_SXS); u16* gb = (u16*)(ws + WS_SB); u16* gc = (u16*)(ws + WS_SC);
#pragma unroll 4
        for (int t = 0; t < 128; ++t) {
            const float nxt = (t < 127) ? bf2f(col[(size_t)(t + 1) * PC]) : (rv ? bf2f(col[(size_t)128 * PC]) : 0.f);
            const u16 bv = f2bf(silu_f(w0 * prev + w1 * cur + w2 * nxt + cb));
            if (cidx < 256) { gx[(size_t)(row0 + t) * 256 + cidx] = bv; XT[cidx * 136 + kpos(t)] = bv; }
            else if (cidx < 384) { gb[(size_t)(row0 + t) * 128 + cidx - 256] = bv; BT[(cidx - 256) * 136 + kpos(t)] = bv; }
            else gc[(size_t)(row0 + t) * 128 + cidx - 384] = bv;
            prev = cur; cur = nxt;
        }
    }
    __syncthreads();
    {
        const int dir = wave >> 2, h = wave & 3, g = h >> 1;
        f32x16 acc[2][2];
#pragma unroll
        for (int mi = 0; mi < 2; ++mi)
#pragma unroll
            for (int ni = 0; ni < 2; ++ni) acc[mi][ni] = zero16();
#pragma unroll
        for (int s = 0; s < 8; ++s) {
            const float4 wa = *(const float4*)(wvp + wave * 128 + 16 * s + 8 * hh), wb = *(const float4*)(wvp + wave * 128 + 16 * s + 8 * hh + 4);
            const float wts[8] = {wa.x, wa.y, wa.z, wa.w, wb.x, wb.y, wb.z, wb.w};
            bf16x8 aw[2], bb[2];
#pragma unroll
            for (int mi = 0; mi < 2; ++mi) {
                const uint4 rw = *(const uint4*)(XT + (h * 64 + mi * 32 + r) * 136 + 16 * s + 8 * hh);
                float x[8]; unpack8(rw, x);
#pragma unroll
                for (int j = 0; j < 8; ++j) x[j] *= wts[j];
                const uint4 pk = pack8(x); aw[mi] = __builtin_bit_cast(bf16x8, pk);
            }
#pragma unroll
            for (int ni = 0; ni < 2; ++ni) bb[ni] = *(const bf16x8*)(BT + (g * 64 + ni * 32 + r) * 136 + 16 * s + 8 * hh);
#pragma unroll
            for (int mi = 0; mi < 2; ++mi)
#pragma unroll
                for (int ni = 0; ni < 2; ++ni) acc[mi][ni] = MFMA32(aw[mi], bb[ni], acc[mi][ni]);
        }
        float* st = (float*)(ws + WS_SST) + ((size_t)((b * 2 + dir) * NCH + c) * 4 + h) * 4096;
#pragma unroll
        for (int mi = 0; mi < 2; ++mi)
#pragma unroll
            for (int ni = 0; ni < 2; ++ni)
#pragma unroll
                for (int i = 0; i < 16; ++i) st[(mi * 32 + crow(i, hh)) * 64 + ni * 32 + r] = acc[mi][ni][i];
    }
    __syncthreads();
}

constexpr int S5_BU_PITCH = 132;
constexpr int S5_BU_BYTES = 32 * S5_BU_PITCH * 4;
DI void s5_chunk_item(const Params& P, int layer, int ci, unsigned char* smem) {
    unsigned char* ws = P.ws;
    const int tid = opq_tid(), lane = tid & 63, wave = tid >> 6, r = lane & 31, hh = lane >> 5;
    const int b = ci / NCH, c = ci % NCH, row0 = b * LSEQ + c * 128;
    const u16* pb = (const u16*)(ws + WS_P);
    const float* s5a = (const float*)(ws + WS_S5A); const u16* s5bt = (const u16*)(ws + WS_S5BT);
    float* Bu = (float*)(smem + wave * S5_BU_BYTES);
    float* F = (float*)(ws + WS_S5F);
#pragma unroll 1
    for (int gi = 0; gi < 2; ++gi) {
        const int g = wave + 8 * gi;
#pragma unroll 1
        for (int dir = 0; dir < 2; ++dir) {
            const size_t ldg = (size_t)(layer * 2 + dir) * 16 + g;
            const float ar = s5a[(ldg * 64 + lane) * 2], ai = s5a[(ldg * 64 + lane) * 2 + 1], nai = -ai;
            bf16x8 bfr[4];
#pragma unroll
            for (int ct = 0; ct < 4; ++ct) bfr[ct] = *(const bf16x8*)(s5bt + (ldg * 128 + ct * 32 + r) * 16 + 8 * hh);
            float sre = 0.f, sim = 0.f;
#pragma unroll 1
            for (int tbi = 0; tbi < 4; ++tbi) {
                const int tb = dir ? 3 - tbi : tbi;
                const bf16x8 af = *(const bf16x8*)(pb + (size_t)(row0 + tb * 32 + r) * PC + C_S5U + g * 16 + 8 * hh);
#pragma unroll
                for (int ct = 0; ct < 4; ++ct) {
                    const f32x16 acc = MFMA32(af, bfr[ct], zero16());
#pragma unroll
                    for (int i = 0; i < 16; ++i) Bu[crow(i, hh) * S5_BU_PITCH + ct * 32 + r] = acc[i];
                }
                wave_lds_fence();
#pragma unroll 1
                for (int hb = 0; hb < 2; ++hb) {
                    float bre[16], bim[16];
#pragma unroll
                    for (int q = 0; q < 16; ++q) {
                        const int tti = hb * 16 + q, tt = dir ? 31 - tti : tti;
                        bre[q] = Bu[tt * S5_BU_PITCH + lane]; bim[q] = Bu[tt * S5_BU_PITCH + 64 + lane];
                    }
                    wave_lds_fence();
#pragma unroll
                    for (int q = 0; q < 16; ++q) {
                        const float nre = fma_asm(ar, sre, fma_asm(nai, sim, bre[q])), nim = fma_asm(ar, sim, fma_asm(ai, sre, bim[q]));
                        sre = nre; sim = nim;
                    }
                }
                wave_lds_fence();
            }
            float* fo = F + ((((size_t)(b * 2 + dir) * NCH + c) * 16 + g) * 64 + lane) * 2;
            fo[0] = sre; fo[1] = sim;
        }
    }
}

DI void ph_prep(const Params& P, int layer, unsigned char* smem) {
    const int tid = opq_tid();
    {
        float* cs = (float*)(smem + LDS_TAB); float* gn = (float*)(smem + LDS_GAIN);
        for (int i = tid; i < 1024; i += NTHR) {
            const int pos = i >> 3, f = i & 7;
            const float inv = expf(-(float)f * (9.210340371976184f / 8.f));
            float sn, cn; sincosf((float)pos * inv, &sn, &cn);
            cs[i * 2] = cn; cs[i * 2 + 1] = sn;
        }
        if (tid < 96) { gn[tid] = P.in[I_MQN][layer * 96 + tid]; gn[96 + tid] = P.in[I_MKN][layer * 96 + tid]; }
        if (tid < 128) gn[192 + tid] = P.in[I_MKVN][layer * 128 + tid];
        if (tid < 32) { gn[320 + tid] = P.in[I_DQN][layer * 32 + tid]; gn[352 + tid] = P.in[I_DKN][layer * 32 + tid]; }
        __syncthreads();
    }
    for (int it = blockIdx.x; it < 396; it += gridDim.x) {
        if (it < 132) s5_chunk_item(P, layer, it, smem);
        else if (it < 264) ssd_chunk_item(P, layer, it - 132, smem);
        else if (it < 330) mla_prep_item(P, it - 264, smem);
        else diff_prep_item(P, it - 330, smem);
        __syncthreads();
    }
}

constexpr int VP = 144;
constexpr int ATT_STAGE = 64 * 208 + 64 * VP;

template <int DK>
DI void attn_pass(const u16* __restrict__ Qg, const u16* __restrict__ Kg, int pitch, const u16* __restrict__ Vg, int qrow, int nkt,
                  float negbound, unsigned char* smem, float (&outv)[2][16]) {
    const int tid = opq_tid(), lane = tid & 63, r = lane & 31, hh = lane >> 5;
    constexpr int KP = DK * 2 + 16;
    constexpr int KCH = DK / 8;
    constexpr int NKC = 64 * KCH;
    constexpr int NQF = DK / 16;
    bf16x8 qf[NQF];
#pragma unroll
    for (int s = 0; s < NQF; ++s) qf[s] = *(const bf16x8*)(Qg + (size_t)qrow * pitch + 16 * s + 8 * hh);
    const int kc0 = tid, kc1 = tid + 512;
    const int k_row0 = kc0 / KCH, k_col0 = kc0 % KCH, k_row1 = kc1 / KCH, k_col1 = kc1 % KCH;
    const int v_row = tid >> 3, v_col = tid & 7;
    uint4 rk0 = make_uint4(0, 0, 0, 0), rk1 = make_uint4(0, 0, 0, 0), rv;
    auto load_tile = [&](int kt) {
        const size_t key0 = (size_t)kt * 64;
        if (kc0 < NKC) rk0 = *(const uint4*)(Kg + (key0 + k_row0) * pitch + k_col0 * 8);
        if (kc1 < NKC) rk1 = *(const uint4*)(Kg + (key0 + k_row1) * pitch + k_col1 * 8);
        rv = *(const uint4*)(Vg + (size_t)v_row * LSEQ + key0 + v_col * 8);
    };
    auto store_tile = [&](int st) {
        unsigned char* sb = smem + st * ATT_STAGE;
        if (kc0 < NKC) *(uint4*)(sb + k_row0 * KP + k_col0 * 16) = rk0;
        if (kc1 < NKC) *(uint4*)(sb + k_row1 * KP + k_col1 * 16) = rk1;
        *(uint4*)(sb + 64 * KP + v_row * VP + v_col * 16) = rv;
    };
    f32x16 o[2]; o[0] = zero16(); o[1] = zero16();
    float l = 0.f;
    load_tile(0); store_tile(0);
    __syncthreads();
#pragma unroll 2
    for (int kt = 0; kt < nkt; ++kt) {
        const unsigned char* sb = smem + (kt & 1) * ATT_STAGE;
        const unsigned char* vb = sb + 64 * KP;
        if (kt + 1 < nkt) load_tile(kt + 1);
#pragma unroll
        for (int k2 = 0; k2 < 2; ++k2) {
            f32x16 sacc;
#pragma unroll
            for (int i = 0; i < 16; ++i) sacc[i] = negbound;
#pragma unroll
            for (int s = 0; s < NQF; ++s) sacc = MFMA32(ld_frag(sb + (k2 * 32 + r) * KP + s * 32 + hh * 16), qf[s], sacc);
            float pv[16];
#pragma unroll
            for (int i = 0; i < 16; ++i) { pv[i] = __builtin_amdgcn_exp2f(sacc[i]); l += pv[i]; }
            const uint4 a = pack8(pv), c = pack8(pv + 8);
            const bf16x8 pf0 = __builtin_bit_cast(bf16x8, a), pf1 = __builtin_bit_cast(bf16x8, c);
#pragma unroll
            for (int dt = 0; dt < 2; ++dt) {
                o[dt] = MFMA32(ld_frag(vb + (dt * 32 + r) * VP + (2 * k2) * 32 + hh * 16), pf0, o[dt]);
                o[dt] = MFMA32(ld_frag(vb + (dt * 32 + r) * VP + (2 * k2 + 1) * 32 + hh * 16), pf1, o[dt]);
            }
        }
        if (kt + 1 < nkt) store_tile((kt + 1) & 1);
        __syncthreads();
    }
    l += __shfl_xor(l, 32, 64);
    const float il = 1.f / l;
#pragma unroll
    for (int dt = 0; dt < 2; ++dt)
#pragma unroll
        for (int i = 0; i < 16; ++i) outv[dt][i] = o[dt][i] * il;
}

template <bool MLA>
DI void attn_item(const Params& P, int layer, int b, int head, int qt, float negbound, float lam, float lam_init, unsigned char* smem) {
    unsigned char* ws = P.ws;
    const int tid = opq_tid(), lane = tid & 63, wave = tid >> 6, r = lane & 31, hh = lane >> 5;
    constexpr int PITCH = MLA ? 96 : 64;
    const u16* Qg = (const u16*)(ws + (MLA ? WS_QM : WS_QD)) + (size_t)(b * 4 + head) * LSEQ * PITCH;
    const u16* Kg = (const u16*)(ws + (MLA ? WS_KM : WS_KD)) + (size_t)(b * 4 + head) * LSEQ * PITCH;
    const u16* Vg = (const u16*)(ws + (MLA ? WS_VTM : WS_VTD)) + (size_t)(b * 4 + head) * 64 * LSEQ;
    const int q0 = qt * 256;
    const int nkt = (qt == 0) ? (CTX / 64) : (LSEQ / 64);
    const int qrow = q0 + wave * 32 + r;
    float outv[2][16];
    if (MLA) {
        attn_pass<96>(Qg, Kg, 96, Vg, qrow, nkt, negbound, smem, outv);
    } else {
        float o1[2][16];
        attn_pass<32>(Qg, Kg, 64, Vg, qrow, nkt, negbound, smem, o1);
        attn_pass<32>(Qg + 32, Kg + 32, 64, Vg, qrow, nkt, negbound, smem, outv);
        float ss = 0.f;
#pragma unroll
        for (int dt = 0; dt < 2; ++dt)
#pragma unroll
            for (int i = 0; i < 16; ++i) { const float v = o1[dt][i] - lam * outv[dt][i]; outv[dt][i] = v; ss += v * v; }
        ss += __shfl_xor(ss, 32, 64);
        const float rstd = rsqrtf(ss * (1.f / 64.f) + EPS) * (1.f - lam_init);
        const float* sub = P.in[I_DSUB] + layer * 64;
#pragma unroll
        for (int dt = 0; dt < 2; ++dt)
#pragma unroll
            for (int i = 0; i < 16; ++i) outv[dt][i] *= rstd * sub[dt * 32 + crow(i, hh)];
    }
    unsigned char* ob = smem + wave * (32 * 144);
#pragma unroll
    for (int dt = 0; dt < 2; ++dt)
#pragma unroll
        for (int q4 = 0; q4 < 4; ++q4) {
            uint2 w;
            w.x = pack_bf2(outv[dt][4 * q4], outv[dt][4 * q4 + 1]); w.y = pack_bf2(outv[dt][4 * q4 + 2], outv[dt][4 * q4 + 3]);
            *(uint2*)(ob + r * 144 + (dt * 32 + 8 * q4 + 4 * hh) * 2) = w;
        }
    wave_lds_fence();
    u16* cat = (u16*)(ws + WS_CAT);
    const int colbase = (MLA ? 0 : 768) + head * 64;
#pragma unroll
    for (int it = 0; it < 4; ++it) {
        const int idx = it * 64 + lane, qr = idx >> 3, ch = idx & 7;
        const uint4 v = *(const uint4*)(ob + qr * 144 + ch * 16);
        const size_t row = (size_t)b * LSEQ + q0 + wave * 32 + qr;
        *(uint4*)(cat + row * 1024 + colbase + ch * 8) = v;
    }
    __syncthreads();
}

DI void ph_attn(const Params& P, int layer, unsigned char* smem) {
    unsigned char* ws = P.ws;
    const int tid = opq_tid();
    if (blockIdx.x < 128) {
        const int e = blockIdx.x * NTHR + tid;
        const int el = e & 4095, h = (e >> 12) & 3, dir = (e >> 14) & 1, b = e >> 15;
        float* st = (float*)(ws + WS_SST); const float* cd = (const float*)(ws + WS_SCD);
        float hc = 0.f;
#pragma unroll 6
        for (int k = 0; k < NCH; ++k) {
            const int c = chunk_at(dir, k);
            const size_t off = ((size_t)((b * 2 + dir) * NCH + c) * 4 + h) * 4096 + el;
            const float s = st[off];
            st[off] = hc;
            hc = hc * cd[((b * 2 + dir) * NCH + c) * 4 + h] + s;
        }
    } else if (blockIdx.x < 136) {
        const int e = (blockIdx.x - 128) * NTHR + tid;
        const int p = e & 63, g = (e >> 6) & 15, dir = (e >> 10) & 1, b = e >> 11;
        const float* s5a = (const float*)(ws + WS_S5A);
        const size_t ldg = (size_t)(layer * 2 + dir) * 16 + g;
        float ar = s5a[(ldg * 64 + p) * 2], ai = s5a[(ldg * 64 + p) * 2 + 1];
#pragma unroll
        for (int q = 0; q < 7; ++q) { const float nr = ar * ar - ai * ai, ni = 2.f * ar * ai; ar = nr; ai = ni; }
        float* F = (float*)(ws + WS_S5F);
        float cr = 0.f, cim = 0.f;
#pragma unroll 6
        for (int k = 0; k < NCH; ++k) {
            const int c = chunk_at(dir, k);
            float* fo = F + ((((size_t)(b * 2 + dir) * NCH + c) * 16 + g) * 64 + p) * 2;
            const float fr = fo[0], fi = fo[1];
            fo[0] = cr; fo[1] = cim;
            const float nr = ar * cr - ai * cim + fr, ni = ar * cim + ai * cr + fi;
            cr = nr; cim = ni;
        }
    }
    float nb_m, nb_d, lam;
    {
        const int lane = tid & 63;
        float m = fabsf(P.in[I_MQN][layer * 96 + lane] * P.in[I_MKN][layer * 96 + lane]);
        if (lane < 32) m = fmaxf(m, fabsf(P.in[I_MQN][layer * 96 + 64 + lane] * P.in[I_MKN][layer * 96 + 64 + lane]));
        float m2 = 0.f, s1 = 0.f, s2 = 0.f;
        if (lane < 32) {
            m2 = fabsf(P.in[I_DQN][layer * 32 + lane] * P.in[I_DKN][layer * 32 + lane]);
            s1 = P.in[I_DLQ1][layer * 32 + lane] * P.in[I_DLK1][layer * 32 + lane];
            s2 = P.in[I_DLQ2][layer * 32 + lane] * P.in[I_DLK2][layer * 32 + lane];
        }
#pragma unroll
        for (int o = 32; o >= 1; o >>= 1) {
            m = fmaxf(m, __shfl_xor(m, o, 64)); m2 = fmaxf(m2, __shfl_xor(m2, o, 64));
            s1 += __shfl_xor(s1, o, 64); s2 += __shfl_xor(s2, o, 64);
        }
        nb_m = -(m * 1.413546682e+01f);
        nb_d = -(m2 * 8.161115573e+00f);
        lam = expf(s1) - expf(s2) + (0.8f - 0.6f * expf(-0.3f * (float)layer));
    }
    const float lam_init = 0.8f - 0.6f * expf(-0.3f * (float)layer);
    __syncthreads();
    for (int it = blockIdx.x; it < 528; it += gridDim.x) {
        const int idx = (it < 264) ? it : it - 264;
        const int b = (idx & 7) >> 2, head = idx & 3, qt = ((idx >> 3) + 1) % 33;
        if (it < 264) attn_item<false>(P, layer, b, head, qt, nb_d, lam, lam_init, smem);
        else          attn_item<true>(P, layer, b, head, qt, nb_m, 0.f, 0.f, smem);
    }
}

constexpr int SO_B = 0, SO_C = 36864, SO_XT = 73728, SO_E = 143360, SO_DT = 147456;
constexpr int SO_YP = 528;
DI void ssd_out_item(const Params& P, int layer, int ci, unsigned char* smem) {
    unsigned char* ws = P.ws;
    const int tid = opq_tid(), lane = tid & 63, wave = tid >> 6, r = lane & 31, hh = lane >> 5;
    const int b = ci / NCH, c = ci % NCH, row0 = b * LSEQ + c * 128;
    unsigned char* Bm = smem + SO_B; unsigned char* Cm = smem + SO_C; u16* XT = (u16*)(smem + SO_XT);
    float* Es = (float*)(smem + SO_E); float* dts = (float*)(smem + SO_DT);
    {
        const u16* gb = (const u16*)(ws + WS_SB); const u16* gc = (const u16*)(ws + WS_SC); const u16* gx = (const u16*)(ws + WS_SXS);
#pragma unroll
        for (int it = 0; it < 4; ++it) {
            const int idx = it * NTHR + tid, t = idx >> 4, cch = idx & 15, g = cch >> 3, n8 = cch & 7;
            *(uint4*)(Bm + g * 18432 + t * 144 + n8 * 16) = *(const uint4*)(gb + (size_t)(row0 + t) * 128 + cch * 8);
            *(uint4*)(Cm + g * 18432 + t * 144 + n8 * 16) = *(const uint4*)(gc + (size_t)(row0 + t) * 128 + cch * 8);
        }
#pragma unroll 2
        for (int it = 0; it < 8; ++it) {
            const int idx = it * NTHR + tid, cc = idx & 255, kq = idx >> 8;
            const int k16 = kq >> 1, hb = kq & 1;
            const u16* src = gx + (size_t)(row0 + 16 * k16 + 4 * hb) * 256 + cc;
            uint4 o;
            o.x = (unsigned)src[0] | ((unsigned)src[256] << 16);
            o.y = (unsigned)src[512] | ((unsigned)src[768] << 16);
            o.z = (unsigned)src[8 * 256] | ((unsigned)src[9 * 256] << 16);
            o.w = (unsigned)src[10 * 256] | ((unsigned)src[11 * 256] << 16);
            *(uint4*)(XT + cc * 136 + 16 * k16 + 8 * hb) = o;
        }
        const float* ge = (const float*)(ws + WS_SE); const float* gdt = (const float*)(ws + WS_SDT);
#pragma unroll
        for (int it = 0; it < 2; ++it) {
            const int idx = it * NTHR + tid, t = idx >> 3, w = idx & 7;
            Es[w * 128 + t] = ge[(size_t)(row0 + t) * 8 + w];
            dts[w * 128 + t] = gdt[(size_t)(row0 + t) * 8 + w];
        }
    }
    __syncthreads();
    const int h = wave & 3, th = wave >> 2, g = h >> 1;
    f32x16 Y[2][2];
#pragma unroll
    for (int a = 0; a < 2; ++a)
#pragma unroll
        for (int q = 0; q < 2; ++q) Y[a][q] = zero16();
    const unsigned char* Bg = Bm + g * 18432; const unsigned char* Cg = Cm + g * 18432;
#pragma unroll 1
    for (int dir = 0; dir < 2; ++dir) {
        const int w = dir * 4 + h;
        bf16x8 hf[2][4];
        {
            const float* hin = (const float*)(ws + WS_SST) + ((size_t)((b * 2 + dir) * NCH + c) * 4 + h) * 4096;
#pragma unroll
            for (int pt = 0; pt < 2; ++pt)
#pragma unroll
                for (int s = 0; s < 4; ++s) {
                    const float4 x0 = *(const float4*)(hin + (pt * 32 + r) * 64 + 16 * s + 8 * hh), x1 = *(const float4*)(hin + (pt * 32 + r) * 64 + 16 * s + 8 * hh + 4);
                    uint4 pk; pk.x = pack_bf2(x0.x, x0.y); pk.y = pack_bf2(x0.z, x0.w); pk.z = pack_bf2(x1.x, x1.y); pk.w = pack_bf2(x1.z, x1.w);
                    hf[pt][s] = __builtin_bit_cast(bf16x8, pk);
                }
        }
#pragma unroll
        for (int tti = 0; tti < 2; ++tti) {
            const int tt = 2 * th + tti, t = tt * 32 + r;
            const float Et = Es[w * 128 + t];
            bf16x8 cq[4];
#pragma unroll
            for (int s = 0; s < 4; ++s) cq[s] = ld_frag(Cg + t * 144 + s * 32 + hh * 16);
            const int jlo = dir ? tt : 0, jhi = dir ? 3 : tt;
#pragma unroll 1
            for (int jt = jlo; jt <= jhi; ++jt) {
                f32x16 ga = zero16();
#pragma unroll
                for (int s = 0; s < 4; ++s) ga = MFMA32(ld_frag(Bg + (jt * 32 + r) * 144 + s * 32 + hh * 16), cq[s], ga);
                float lv[16];
#pragma unroll
                for (int i = 0; i < 16; ++i) {
                    const int j = jt * 32 + crow(i, hh);
                    const bool valid = dir ? (j >= t) : (j <= t);
                    const float arg = valid ? (Et - Es[w * 128 + j]) : 0.f;
                    lv[i] = valid ? ga[i] * __expf(arg) * dts[w * 128 + j] : 0.f;
                }
                const uint4 p0 = pack8(lv), p1 = pack8(lv + 8);
                const bf16x8 lf0 = __builtin_bit_cast(bf16x8, p0), lf1 = __builtin_bit_cast(bf16x8, p1);
#pragma unroll
                for (int pt = 0; pt < 2; ++pt) {
                    const u16* xr = XT + (h * 64 + pt * 32 + r) * 136 + 32 * jt + 8 * hh;
                    Y[pt][tti] = MFMA32(*(const bf16x8*)(xr), lf0, Y[pt][tti]);
                    Y[pt][tti] = MFMA32(*(const bf16x8*)(xr + 16), lf1, Y[pt][tti]);
                }
            }
            const float sc = __expf(Et);
#pragma unroll
            for (int pt = 0; pt < 2; ++pt) {
                f32x16 ho = zero16();
#pragma unroll
                for (int s = 0; s < 4; ++s) ho = MFMA32(hf[pt][s], cq[s], ho);
#pragma unroll
                for (int i = 0; i < 16; ++i) Y[pt][tti][i] += sc * ho[i];
            }
        }
    }
    {
        const float dsk = P.in[I_SD][layer * 4 + h];
#pragma unroll
        for (int tti = 0; tti < 2; ++tti) {
            const int t = (2 * th + tti) * 32 + r;
#pragma unroll
            for (int pt = 0; pt < 2; ++pt)
#pragma unroll
                for (int i = 0; i < 16; ++i) Y[pt][tti][i] += dsk * bf2f(XT[(h * 64 + pt * 32 + crow(i, hh)) * 136 + kpos(t)]);
        }
    }
    __syncthreads();
    {
        unsigned char* Ys = smem + SO_XT;
#pragma unroll
        for (int tti = 0; tti < 2; ++tti) {
            const int t = (2 * th + tti) * 32 + r;
#pragma unroll
            for (int pt = 0; pt < 2; ++pt)
#pragma unroll
                for (int q4 = 0; q4 < 4; ++q4) {
                    uint2 o; o.x = pack_bf2(Y[pt][tti][4 * q4], Y[pt][tti][4 * q4 + 1]); o.y = pack_bf2(Y[pt][tti][4 * q4 + 2], Y[pt][tti][4 * q4 + 3]);
                    *(uint2*)(Ys + t * SO_YP + (h * 64 + pt * 32 + 8 * q4 + 4 * hh) * 2) = o;
                }
        }
    }
    __syncthreads();
    {
        const unsigned char* Ys = smem + SO_XT;
        const u16* pb = (const u16*)(ws + WS_P); u16* cat = (u16*)(ws + WS_CAT);
        const int c8 = tid & 31, tl = tid >> 5;
        float gn[8];
#pragma unroll
        for (int j = 0; j < 8; ++j) gn[j] = P.in[I_SNORM][layer * 256 + c8 * 8 + j];
#pragma unroll 2
        for (int it = 0; it < 8; ++it) {
            const int t = it * 16 + tl;
            const uint4 yr = *(const uint4*)(Ys + t * SO_YP + c8 * 16);
            const uint4 zr = *(const uint4*)(pb + (size_t)(row0 + t) * PC + C_SZ + c8 * 8);
            float y[8], z[8]; unpack8(yr, y); unpack8(zr, z);
            float ss = 0.f;
#pragma unroll
            for (int j = 0; j < 8; ++j) { y[j] *= silu_f(z[j]); ss += y[j] * y[j]; }
#pragma unroll
            for (int o = 16; o >= 1; o >>= 1) ss += __shfl_xor(ss, o, 64);
            const float rstd = rsqrtf(ss * (1.f / 256.f) + EPS);
#pragma unroll
            for (int j = 0; j < 8; ++j) y[j] *= rstd * gn[j];
            *(uint4*)(cat + (size_t)(row0 + t) * 1024 + 256 + c8 * 8) = pack8(y);
        }
    }
    __syncthreads();
}

DI float gelu_tanh(float x) {
    const float z = 0.7978845608028654f * (x + 0.044715f * x * x * x);
    const float th = 1.f - 2.f / (1.f + __expf(2.f * z));
    return 0.5f * x * (1.f + th);
}

typedef __attribute__((ext_vector_type(4))) float f32x4;
#define MFMA16(a, b, c) __builtin_amdgcn_mfma_f32_16x16x32_bf16((a), (b), (c), 0, 0, 0)
DI void s5_out_item(const Params& P, int layer, int ci, unsigned char* smem) {
    unsigned char* ws = P.ws;
    const int tid = opq_tid(), lane = tid & 63, wave = tid >> 6, r = lane & 31, hh = lane >> 5;
    const int r16 = lane & 15, kq = lane >> 4;
    const int b = ci / NCH, c = ci % NCH, row0 = b * LSEQ + c * 128;
    const u16* pb = (const u16*)(ws + WS_P);
    const float* s5a = (const float*)(ws + WS_S5A); const u16* s5bt = (const u16*)(ws + WS_S5BT); const u16* s5ct = (const u16*)(ws + WS_S5CT);
    float* Bu = (float*)(smem + wave * S5_BU_BYTES);
    const float* F = (const float*)(ws + WS_S5F);
    u16* Gg = (u16*)(ws + WS_HID);
#pragma unroll 1
    for (int gi = 0; gi < 2; ++gi) {
        const int g = wave + 8 * gi;
        f32x4 yv[4][2];
#pragma unroll
        for (int q = 0; q < 4; ++q) { yv[q][0] = (f32x4){0.f, 0.f, 0.f, 0.f}; yv[q][1] = (f32x4){0.f, 0.f, 0.f, 0.f}; }
        bf16x8 dfrag;
        {
            const unsigned dv = (unsigned)f2bf(P.in[I_5D][layer * 256 + g * 16 + r16]);
            unsigned w[4];
#pragma unroll
            for (int q = 0; q < 4; ++q) {
                const int k0 = 8 * kq + 2 * q;
                w[q] = (k0 == r16) ? dv : ((k0 + 1 == r16) ? (dv << 16) : 0u);
            }
            const uint4 dq = make_uint4(w[0], w[1], w[2], w[3]);
            dfrag = __builtin_bit_cast(bf16x8, dq);
        }
#pragma unroll
        for (int dir = 0; dir < 2; ++dir) {
            asm volatile("" ::: "memory");
            const size_t ldg = (size_t)(layer * 2 + dir) * 16 + g;
            const float ar = s5a[(ldg * 64 + lane) * 2], ai = s5a[(ldg * 64 + lane) * 2 + 1], nai = -ai;
            bf16x8 bfr[4], cfr[4];
#pragma unroll
            for (int ct = 0; ct < 4; ++ct) bfr[ct] = *(const bf16x8*)(s5bt + (ldg * 128 + ct * 32 + r) * 16 + 8 * hh);
#pragma unroll
            for (int s4 = 0; s4 < 4; ++s4) cfr[s4] = *(const bf16x8*)(s5ct + (ldg * 16 + r16) * 128 + 32 * s4 + 8 * kq);
            const float* fi = F + ((((size_t)(b * 2 + dir) * NCH + c) * 16 + g) * 64 + lane) * 2;
            float sre = fi[0], sim = fi[1];
#pragma unroll
            for (int tbi = 0; tbi < 4; ++tbi) {
                const int tb = dir ? 3 - tbi : tbi;
                const bf16x8 af = *(const bf16x8*)(pb + (size_t)(row0 + tb * 32 + r) * PC + C_S5U + g * 16 + 8 * hh);
#pragma unroll
                for (int ct = 0; ct < 4; ++ct) {
                    const f32x16 acc = MFMA32(af, bfr[ct], zero16());
#pragma unroll
                    for (int i = 0; i < 16; ++i) Bu[crow(i, hh) * S5_BU_PITCH + ct * 32 + r] = acc[i];
                }
                wave_lds_fence();
#pragma unroll 1
                for (int hb = 0; hb < 2; ++hb) {
                    float bre[16], bim[16];
#pragma unroll
                    for (int q = 0; q < 16; ++q) {
                        const int tti = hb * 16 + q, tt = dir ? 31 - tti : tti;
                        bre[q] = Bu[tt * S5_BU_PITCH + lane]; bim[q] = Bu[tt * S5_BU_PITCH + 64 + lane];
                    }
                    wave_lds_fence();
#pragma unroll
                    for (int q = 0; q < 16; ++q) {
                        const int tti = hb * 16 + q, tt = dir ? 31 - tti : tti;
                        const float nre = fma_asm(ar, sre, fma_asm(nai, sim, bre[q])), nim = fma_asm(ar, sim, fma_asm(ai, sre, bim[q]));
                        sre = nre; sim = nim;
                        Bu[tt * S5_BU_PITCH + lane] = __uint_as_float(pack_bf2(sre, sim));
                    }
                }
                wave_lds_fence();
#pragma unroll
                for (int ts = 0; ts < 2; ++ts) {
#pragma unroll
                    for (int s4 = 0; s4 < 4; ++s4)
                        yv[tb][ts] = MFMA16(ld_frag((const unsigned char*)Bu + (ts * 16 + r16) * (S5_BU_PITCH * 4) + s4 * 64 + kq * 16), cfr[s4], yv[tb][ts]);
                    if (dir == 0) {
                        uint4 uz = make_uint4(0, 0, 0, 0);
                        if (kq < 2) uz = *(const uint4*)(pb + (size_t)(row0 + tb * 32 + ts * 16 + r16) * PC + C_S5U + g * 16 + 8 * kq);
                        yv[tb][ts] = MFMA16(__builtin_bit_cast(bf16x8, uz), dfrag, yv[tb][ts]);
                    }
                }
                wave_lds_fence();
            }
        }
        {
            int gofs = (row0 + 4 * kq) * 256 + g * 16 + r16;
            asm volatile("" : "+v"(gofs));
            u16* gp = Gg + gofs;
#pragma unroll
            for (int tb = 0; tb < 4; ++tb)
#pragma unroll
                for (int ts = 0; ts < 2; ++ts)
#pragma unroll
                    for (int i = 0; i < 4; ++i) gp[(tb * 32 + ts * 16 + i) * 256] = f2bf(gelu_tanh(yv[tb][ts][i]));
        }
    }
    __syncthreads();
    unsigned char* G = smem;
#pragma unroll
    for (int it = 0; it < 8; ++it) {
        const int idx = it * NTHR + tid, t = idx >> 5, c8 = idx & 31;
        *(uint4*)(G + t * 528 + c8 * 16) = *(const uint4*)(Gg + (size_t)(row0 + t) * 256 + c8 * 8);
    }
    __syncthreads();
    {
        const int tq = wave & 3, nh = wave >> 2;
        const u16* wg = (const u16*)(ws + WS_WGLU);
        f32x16 acc[4];
#pragma unroll
        for (int ni = 0; ni < 4; ++ni) acc[ni] = zero16();
#pragma unroll 4
        for (int s = 0; s < 16; ++s) {
            const bf16x8 a = ld_frag(G + (tq * 32 + r) * 528 + s * 32 + hh * 16);
#pragma unroll
            for (int ni = 0; ni < 4; ++ni)
                acc[ni] = MFMA32(a, *(const bf16x8*)(wg + (size_t)(nh * 128 + ni * 32 + r) * 256 + 16 * s + 8 * hh), acc[ni]);
        }
        u16* cat = (u16*)(ws + WS_CAT);
#pragma unroll
        for (int ni = 0; ni < 4; ++ni) {
            const int n = nh * 128 + ni * 32 + r;
            const float bg = P.in[I_5BGLU][layer * 256 + n];
#pragma unroll
            for (int i = 0; i < 16; ++i) {
                const int t = tq * 32 + crow(i, hh);
                const float gv = bf2f(*(const u16*)(G + t * 528 + n * 2));
                const float o = gv / (1.f + __expf(-(acc[ni][i] + bg)));
                cat[(size_t)(row0 + t) * 1024 + 512 + n] = f2bf(o);
            }
        }
    }
    __syncthreads();
}

DI void ph_ssm_out(const Params& P, int layer, unsigned char* smem) {
    for (int it = blockIdx.x; it < 264; it += gridDim.x) {
        if (it < 132) s5_out_item(P, layer, it, smem);
        else ssd_out_item(P, layer, it - 132, smem);
    }
}

DI void ph_gemm_out(const Params& P, int layer, unsigned char* smem) {
    unsigned char* ws = P.ws;
    const u16* cat = (const u16*)(ws + WS_CAT); const u16* wt = (const u16*)(ws + WS_WOUT); float* xb = (float*)(ws + WS_X);
    const float* mods = (const float*)(ws + WS_MODS);
    const int lane = opq_tid() & 63;
    for (int tile = blockIdx.x; tile < (T / 128) * 8; tile += gridDim.x) {
        const int mt = tile >> 3, nt = tile & 7, m0 = mt * 128, n0 = nt * 128;
        const int b = m0 / LSEQ, u = m0 % LSEQ, which = (u < CTX) ? 2 : b;
        const float* gate = mods + ((size_t)layer * 3 + which) * 6144 + 2 * 1024;
        gemm_tile<2, 4, 2, 1>(smem, [&](int r) { return cat + (size_t)(m0 + r) * 1024; }, wt, 1024, n0, 1024,
            [&](f32x16 (&acc)[2][1], int r0, int c0) {
                const int col = n0 + c0 + (lane & 31);
                const float gt = gate[col];
#pragma unroll
                for (int mi = 0; mi < 2; ++mi)
#pragma unroll
                    for (int i = 0; i < 16; ++i) {
                        float* xp = xb + (size_t)(m0 + r0 + mi * 32 + crow(i, lane >> 5)) * 1024 + col;
                        *xp += gt * acc[mi][0][i];
                    }
            });
    }
}

DI void ph_norm2_route(const Params& P, int layer, unsigned char* smem) {
    unsigned char* ws = P.ws;
    const int tid = opq_tid(), lane = tid & 63, wave = tid >> 6;
    float* wr = (float*)smem;
    {
        const float* wg = P.in[I_MWG] + (size_t)layer * 1024 * 4; const float* we = P.in[I_MWE] + (size_t)layer * 4 * 1024 * 8;
        for (int i = tid; i < 4096; i += NTHR) { const int k = i >> 2, o = i & 3; wr[o * 1024 + k] = wg[i]; }
        for (int i = tid; i < 32768; i += NTHR) { const int e = i & 7, k = (i >> 3) & 1023, g = i >> 13; wr[(4 + g * 8 + e) * 1024 + k] = we[i]; }
    }
    __syncthreads();
    const float* xbuf = (const float*)(ws + WS_X); u16* hn = (u16*)(ws + WS_HN);
    const float* mods = (const float*)(ws + WS_MODS);
    const float* g2n = P.in[I_NORM2] + layer * 1024;
    int* tok_e = (int*)(ws + WS_TOKE); float* tok_w = (float*)(ws + WS_TOKW); int* list = (int*)(ws + WS_LIST);
    int* cnt = (int*)(ws + WS_CTL + CTL_CNT_OFF) + layer * 32;
    float4 gv[4];
#pragma unroll
    for (int i = 0; i < 4; ++i) gv[i] = *(const float4*)(g2n + i * 256 + lane * 4);
    for (int row = blockIdx.x * NWAVE + wave; row < T; row += gridDim.x * NWAVE) {
        const int b = row / LSEQ, u = row % LSEQ, which = (u < CTX) ? 2 : b;
        const float* xr = xbuf + (size_t)row * 1024;
        float4 v[4]; float ss = 0.f;
#pragma unroll
        for (int i = 0; i < 4; ++i) { v[i] = *(const float4*)(xr + i * 256 + lane * 4); ss += v[i].x * v[i].x + v[i].y * v[i].y + v[i].z * v[i].z + v[i].w * v[i].w; }
        ss = wave_sum(ss);
        const float rstd = rsqrtf(ss * (1.f / 1024.f) + EPS);
        const float* sh = mods + ((size_t)layer * 3 + which) * 6144 + 3 * 1024; const float* sc = sh + 1024;
#pragma unroll
        for (int i = 0; i < 4; ++i) {
            const float4 s4 = *(const float4*)(sh + i * 256 + lane * 4), c4 = *(const float4*)(sc + i * 256 + lane * 4);
            v[i].x = v[i].x * rstd * gv[i].x * (1.f + c4.x) + s4.x; v[i].y = v[i].y * rstd * gv[i].y * (1.f + c4.y) + s4.y;
            v[i].z = v[i].z * rstd * gv[i].z * (1.f + c4.z) + s4.z; v[i].w = v[i].w * rstd * gv[i].w * (1.f + c4.w) + s4.w;
            uint2 o; o.x = pack_bf2(v[i].x, v[i].y); o.y = pack_bf2(v[i].z, v[i].w);
            *(uint2*)(hn + (size_t)row * 1024 + i * 256 + lane * 4) = o;
        }
        auto dotw = [&](int o) {
            float a = 0.f;
#pragma unroll
            for (int i = 0; i < 4; ++i) { const float4 w4 = *(const float4*)(wr + o * 1024 + i * 256 + lane * 4); a += v[i].x * w4.x + v[i].y * w4.y + v[i].z * w4.z + v[i].w * w4.w; }
            return wave_sum(a);
        };
        float lg[4];
#pragma unroll
        for (int o = 0; o < 4; ++o) lg[o] = dotw(o) + P.in[I_MBG][layer * 4 + o];
        int gi = 0; float gm = lg[0];
#pragma unroll
        for (int o = 1; o < 4; ++o) if (lg[o] > gm) { gm = lg[o]; gi = o; }
        float den = 0.f;
#pragma unroll
        for (int o = 0; o < 4; ++o) den += __expf(lg[o] - gm);
        const float pg = 1.f / den;
        float le[8];
#pragma unroll
        for (int e = 0; e < 8; ++e) le[e] = dotw(4 + gi * 8 + e) + P.in[I_MBE][(layer * 4 + gi) * 8 + e];
        int e0 = 0; float v0 = le[0];
#pragma unroll
        for (int e = 1; e < 8; ++e) if (le[e] > v0) { v0 = le[e]; e0 = e; }
        int e1 = -1; float v1 = -3.0e38f;
#pragma unroll
        for (int e = 0; e < 8; ++e) if (e != e0 && le[e] > v1) { v1 = le[e]; e1 = e; }
        const float x1 = __expf(v1 - v0);
        const float w0 = pg / (1.f + x1), w1 = pg * x1 / (1.f + x1);
        if (lane == 0) {
            const int ge0 = gi * 8 + e0, ge1 = gi * 8 + e1;
            tok_e[row * 2] = ge0; tok_e[row * 2 + 1] = ge1; tok_w[row * 2] = w0; tok_w[row * 2 + 1] = w1;
            const int p0 = atomicAdd(&cnt[ge0], 1); list[(size_t)ge0 * T + p0] = row * 2;
            const int p1 = atomicAdd(&cnt[ge1], 1); list[(size_t)ge1 * T + p1] = row * 2 + 1;
        }
    }
}

DI int moe_find_tile(const int* cnt, int ti, int ctiles, int& e_out, int& rt_out, int& ct_out, int& ne_out) {
    int base = 0;
    for (int e = 0; e < 32; ++e) {
        const int n = cnt[e]; const int nt = ((n + 127) >> 7) * ctiles;
        if (ti < base + nt) { const int q = ti - base; e_out = e; rt_out = q / ctiles; ct_out = q % ctiles; ne_out = n; return 1; }
        base += nt;
    }
    return 0;
}
DI void ph_moe1(const Params& P, int layer, unsigned char* smem) {
    unsigned char* ws = P.ws;
    const int* cnt = (const int*)(ws + WS_CTL + CTL_CNT_OFF) + layer * 32;
    const int* list = (const int*)(ws + WS_LIST);
    const u16* hn = (const u16*)(ws + WS_HN); const u16* wgu = (const u16*)(ws + WS_WGU); u16* hid = (u16*)(ws + WS_HID);
    const int lane = opq_tid() & 63;
#ifdef DBG_SORTED_LISTS
    {
        const int* tok_e = (const int*)(ws + WS_TOKE); int* wl = (int*)(ws + WS_LIST);
        const int wave = opq_tid() >> 6;
        for (int e = wave; e < 32; e += NWAVE) {
            int base = 0;
            for (int i0 = 0; i0 < 2 * T; i0 += 64) {
                const int en = i0 + lane; const bool m = tok_e[en] == e;
                const unsigned long long bal = __ballot(m);
                if (m) wl[(size_t)e * T + base + __popcll(bal & ((1ull << lane) - 1ull))] = en;
                base += __popcll(bal);
            }
        }
        __syncthreads();
    }
#endif
    for (int ti = blockIdx.x;; ti += gridDim.x) {
        int e, rt, ct, ne;
        if (!moe_find_tile(cnt, ti, 4, e, rt, ct, ne)) break;
        const int* le = list + (size_t)e * T + rt * 128; const int nrow = min(128, ne - rt * 128);
        gemm_tile<4, 2, 1, 2>(smem, [&](int r) { return hn + (size_t)(le[min(r, nrow - 1)] >> 1) * 1024; },
            wgu + (size_t)e * 512 * 1024, 1024, ct * 128, 1024,
            [&](f32x16 (&acc)[1][2], int r0, int c0) {
                const int j = ct * 64 + (c0 >> 6) * 32 + (lane & 31);
#pragma unroll
                for (int i = 0; i < 16; ++i) {
                    const int rr = r0 + crow(i, lane >> 5);
                    if (rr < nrow) { const float gte = acc[0][0][i]; hid[(size_t)le[rr] * 256 + j] = f2bf(silu_f(gte) * acc[0][1][i]); }
                }
            });
    }
}
DI void ph_moe2(const Params& P, int layer, unsigned char* smem) {
    unsigned char* ws = P.ws;
    const int* cnt = (const int*)(ws + WS_CTL + CTL_CNT_OFF) + layer * 32;
    const int* list = (const int*)(ws + WS_LIST); const float* tok_w = (const float*)(ws + WS_TOKW);
    const u16* hid = (const u16*)(ws + WS_HID); const u16* wd = (const u16*)(ws + WS_WD); u16* yb = (u16*)(ws + WS_Y);
    const int lane = opq_tid() & 63;
    for (int ti = blockIdx.x;; ti += gridDim.x) {
        int e, rt, ct, ne;
        if (!moe_find_tile(cnt, ti, 8, e, rt, ct, ne)) break;
        const int* le = list + (size_t)e * T + rt * 128; const int nrow = min(128, ne - rt * 128);
        gemm_tile<2, 4, 2, 1>(smem, [&](int r) { return hid + (size_t)le[min(r, nrow - 1)] * 256; },
            wd + (size_t)e * 1024 * 256, 256, ct * 128, 256,
            [&](f32x16 (&acc)[2][1], int r0, int c0) {
                const int col = ct * 128 + c0 + (lane & 31);
#pragma unroll
                for (int mi = 0; mi < 2; ++mi)
#pragma unroll
                    for (int i = 0; i < 16; ++i) {
                        const int rr = r0 + mi * 32 + crow(i, lane >> 5);
                        if (rr < nrow) { const int en = le[rr]; yb[(size_t)en * 1024 + col] = f2bf(acc[mi][0][i] * tok_w[en]); }
                    }
            });
    }
}

DI void ph_final(const Params& P) {
    unsigned char* ws = P.ws;
#ifdef DBG_DUMPF_OFF
    {
        const float* src = (const float*)(ws + DBG_DUMPF_OFF);
#ifndef DBG_DUMPF_N
#define DBG_DUMPF_N ((size_t)NB * SEQ * D)
#endif
        for (size_t i = (size_t)blockIdx.x * NTHR + threadIdx.x; i < (size_t)NB * SEQ * D; i += (size_t)gridDim.x * NTHR) { float vv = (i < (size_t)(DBG_DUMPF_N)) ? src[i] : 0.f;
#ifdef DBG_AMP
            vv = vv * 1048576.f; vv = vv - floorf(vv);
#endif
            P.out[i] = vv; }
        return;
    }
#endif
#ifdef DBG_DUMP_OFF
    {
        const u16* src = (const u16*)(ws + DBG_DUMP_OFF);
#ifndef DBG_DUMP_N
#define DBG_DUMP_N ((size_t)NB * SEQ * D)
#endif
        for (size_t i = (size_t)blockIdx.x * NTHR + threadIdx.x; i < (size_t)NB * SEQ * D; i += (size_t)gridDim.x * NTHR) { float vv = (i < (size_t)(DBG_DUMP_N)) ? bf2f(src[i]) : 0.f;
#ifdef DBG_AMP
            vv = vv * 4096.f; vv = vv - floorf(vv);
#endif
            P.out[i] = vv; }
        return;
    }
#endif
    const int tid = opq_tid(), lane = tid & 63, wave = tid >> 6;
    const float* xbuf = (const float*)(ws + WS_X); const u16* yb = (const u16*)(ws + WS_Y); const float* mods = (const float*)(ws + WS_MODS);
    for (int lr = blockIdx.x * NWAVE + wave; lr < NB * SEQ; lr += gridDim.x * NWAVE) {
        const int b = lr / SEQ, l = lr % SEQ, row = b * LSEQ + CTX + l;
        const float* xr = xbuf + (size_t)row * 1024;
        const float* g2 = mods + ((size_t)(DEPTH - 1) * 3 + b) * 6144 + 5 * 1024;
        const u16* y0 = yb + (size_t)(2 * row) * 1024; const u16* y1 = y0 + 1024;
#pragma unroll
        for (int i = 0; i < 4; ++i) {
            float4 v = *(const float4*)(xr + i * 256 + lane * 4);
            const uint2 a = *(const uint2*)(y0 + i * 256 + lane * 4), c = *(const uint2*)(y1 + i * 256 + lane * 4);
            const float4 gg = *(const float4*)(g2 + i * 256 + lane * 4);
#ifndef DBG_STOP_L
            v.x += gg.x * (bflo(a.x) + bflo(c.x)); v.y += gg.y * (bfhi(a.x) + bfhi(c.x));
            v.z += gg.z * (bflo(a.y) + bflo(c.y)); v.w += gg.w * (bfhi(a.y) + bfhi(c.y));
#endif
            *(float4*)(P.out + (size_t)lr * 1024 + i * 256 + lane * 4) = v;
        }
    }
}

extern __shared__ __attribute__((aligned(16))) unsigned char g_smem[];
__global__ void __launch_bounds__(NTHR, 2) trunk_fwd(Params P) {
    unsigned char* smem = g_smem;
    volatile LAS unsigned* xbw = (volatile LAS unsigned*)(g_smem + LDS_BYTES);
    XcdBarrier bar; bar.bar = (unsigned*)(P.ws + WS_CTL); bar.x = 0; bar.st = xbw;
    if (P.use_bar) {
        if (threadIdx.x == 0) { xbw[0] = 0u; xbw[1] = 0u; xbw[2] = 0u; xbw[3] = 0u; }
        __syncthreads();
        bar = xcd_barrier_post((unsigned*)(P.ws + WS_CTL), xbw);
    }
#define GRID_BAR() do { if (P.use_bar) xcd_barrier(bar); } while (0)
#ifdef ONLY_PH
#define IN(k) ((k) == ONLY_PH && P.ph_lo <= (k) && (k) < P.ph_hi)
#else
#define IN(k) (P.ph_lo <= (k) && (k) < P.ph_hi)
#endif
    if (P.lay_lo == 0 && IN(0)) { ph_prologue(P, smem); GRID_BAR(); }
    for (int layer = P.lay_lo; layer < P.lay_hi; ++layer) {
        if (IN(1)) { ph_norm1(P, layer, smem); GRID_BAR(); }
        if (IN(2)) { ph_gemm_in(P, smem); GRID_BAR(); }
        if (IN(3)) { ph_prep(P, layer, smem); GRID_BAR(); }
        if (IN(4)) { ph_attn(P, layer, smem); GRID_BAR(); }
        if (IN(5)) { ph_ssm_out(P, layer, smem); GRID_BAR(); }
        if (IN(6)) { ph_gemm_out(P, layer, smem); GRID_BAR(); }
        if (IN(7)) { ph_norm2_route(P, layer, smem); GRID_BAR(); }
        if (IN(8)) { ph_moe1(P, layer, smem); GRID_BAR(); }
        if (IN(9)) { ph_moe2(P, layer, smem); GRID_BAR(); }
    }
    if (P.lay_hi == DEPTH && IN(10)) ph_final(P);
#undef IN
#undef GRID_BAR
}

#ifndef N_LAUNCH_MODE
#define N_LAUNCH_MODE 0
#endif
extern "C" void kernel_launch(void* const* d_in, const int* in_sizes, int n_in, void* d_out, int out_size, void* d_ws, size_t ws_size, hipStream_t stream) {
    static int grid = 0;
    constexpr int DYN_LDS = LDS_BYTES + 16;
    if (grid == 0) {
        if (n_in != 45 || out_size != NB * SEQ * D || ws_size < WS_END) {
            fprintf(stderr, "kernel_launch: unexpected shapes (n_in %d out %d ws %zu need %zu)\n", n_in, out_size, ws_size, (size_t)WS_END); grid = -1; return;
        }
        int dev = 0, cus = 0, per_cu = 0;
        hipGetDevice(&dev); hipDeviceGetAttribute(&cus, hipDeviceAttributeMultiprocessorCount, dev);
        hipFuncSetAttribute((const void*)trunk_fwd, hipFuncAttributeMaxDynamicSharedMemorySize, DYN_LDS);
        hipOccupancyMaxActiveBlocksPerMultiprocessor(&per_cu, (const void*)trunk_fwd, NTHR, DYN_LDS);
        (void)hipGetLastError();
        if (per_cu < 1) fprintf(stderr, "kernel_launch: occupancy query says %d blocks/CU\n", per_cu);
        grid = cus;
    }
    if (grid < 0) return;
    hipMemsetAsync((char*)d_ws + WS_CTL, 0, CTL_BYTES, stream);
    Params p; memset(&p, 0, sizeof(p));
    for (int i = 0; i < 45; ++i) p.in[i] = (const float*)d_in[i];
    p.out = (float*)d_out; p.ws = (unsigned char*)d_ws;
#if N_LAUNCH_MODE == 1
    p.lay_lo = 0; p.lay_hi = DEPTH; p.ph_lo = 0; p.ph_hi = 11; p.use_bar = 1;
    hipLaunchKernelGGL(trunk_fwd, dim3(grid), dim3(NTHR), DYN_LDS, stream, p);
#else
    p.use_bar = 0;
    p.lay_lo = 0; p.lay_hi = 0; p.ph_lo = 0; p.ph_hi = 1;
    hipLaunchKernelGGL(trunk_fwd, dim3(grid), dim3(NTHR), DYN_LDS, stream, p);
    for (int l = 0; l < DEPTH; ++l)
        for (int ph = 1; ph <= 9; ++ph) {
#ifdef DBG_STOP_L
            if (l > DBG_STOP_L || (l == DBG_STOP_L && ph > DBG_STOP_P)) continue;
#endif
            p.lay_lo = l; p.lay_hi = l + 1; p.ph_lo = ph; p.ph_hi = ph + 1;
            hipLaunchKernelGGL(trunk_fwd, dim3(grid), dim3(NTHR), DYN_LDS, stream, p);
        }
    p.lay_lo = DEPTH; p.lay_hi = DEPTH; p.ph_lo = 10; p.ph_hi = 11;
    hipLaunchKernelGGL(trunk_fwd, dim3(grid), dim3(NTHR), DYN_LDS, stream, p);
#endif
}
```

```cpp
#define N_LAUNCH_MODE 1
#include <hip/hip_runtime.h>
#include <cstdio>
#include <cstdint>
#include <cstring>

typedef unsigned short u16;
typedef __attribute__((ext_vector_type(8))) short bf16x8;
typedef __attribute__((ext_vector_type(16))) float f32x16;
typedef __bf16 bf2_t __attribute__((ext_vector_type(2)));
typedef float f2_t __attribute__((ext_vector_type(2)));
#define DI __device__ __forceinline__
#define MFMA32(a, b, c) __builtin_amdgcn_mfma_f32_32x32x16_bf16((a), (b), (c), 0, 0, 0)

constexpr int D = 1024, NB = 2, SEQ = 8192, CTX = 256, LSEQ = CTX + SEQ, T = NB * LSEQ, DEPTH = 4;
constexpr int NTHR = 512, NWAVE = 8;
constexpr int PC = 2432;
constexpr int IN_COLS = 2344;
constexpr int C_MQ = 0, C_MCKV = 384, C_MKR = 512, C_SZ = 544, C_SXBC = 800, C_SDT = 1312, C_S5U = 1320, C_DQ = 1576, C_DK = 1832, C_DV = 2088;
constexpr int NCH = LSEQ / 128;
constexpr float EPS = 1e-6f;
constexpr float LOG2E = 1.4426950408889634f;

constexpr size_t al256(size_t x) { return (x + 255) & ~(size_t)255; }
constexpr size_t WS_CTL = 0;
constexpr size_t CTL_CNT_OFF = 16384;
constexpr size_t CTL_BYTES = 32768;
constexpr size_t WS_MODS = WS_CTL + CTL_BYTES;
constexpr size_t WS_S5A = al256(WS_MODS + (size_t)DEPTH * 3 * 6144 * 4);
constexpr size_t WS_S5BT = al256(WS_S5A + (size_t)DEPTH * 2 * 16 * 64 * 2 * 4);
constexpr size_t WS_S5CT = al256(WS_S5BT + (size_t)DEPTH * 2 * 16 * 128 * 16 * 2);
constexpr size_t WS_X = al256(WS_S5CT + (size_t)DEPTH * 2 * 16 * 16 * 128 * 2);
constexpr size_t WS_HN = al256(WS_X + (size_t)T * D * 4);
constexpr size_t WS_P = al256(WS_HN + (size_t)T * D * 2);
constexpr size_t WS_QM = al256(WS_P + (size_t)T * PC * 2);
constexpr size_t WS_KM = al256(WS_QM + (size_t)NB * 4 * LSEQ * 96 * 2);
constexpr size_t WS_VTM = al256(WS_KM + (size_t)NB * 4 * LSEQ * 96 * 2);
constexpr size_t WS_QD = al256(WS_VTM + (size_t)NB * 4 * 64 * LSEQ * 2);
constexpr size_t WS_KD = al256(WS_QD + (size_t)NB * 4 * LSEQ * 64 * 2);
constexpr size_t WS_VTD = al256(WS_KD + (size_t)NB * 4 * LSEQ * 64 * 2);
constexpr size_t WS_CAT = al256(WS_VTD + (size_t)NB * 4 * 64 * LSEQ * 2);
constexpr size_t WS_SXS = al256(WS_CAT + (size_t)T * D * 2);
constexpr size_t WS_SB = al256(WS_SXS + (size_t)T * 256 * 2);
constexpr size_t WS_SC = al256(WS_SB + (size_t)T * 128 * 2);
constexpr size_t WS_SDT = al256(WS_SC + (size_t)T * 128 * 2);
constexpr size_t WS_SE = al256(WS_SDT + (size_t)T * 8 * 4);
constexpr size_t WS_SST = al256(WS_SE + (size_t)T * 8 * 4);
constexpr size_t WS_SCD = al256(WS_SST + (size_t)NB * 2 * NCH * 4 * 4096 * 4);
constexpr size_t WS_S5F = al256(WS_SCD + (size_t)NB * 2 * NCH * 4 * 4);
constexpr size_t WS_TOKE = al256(WS_S5F + (size_t)NB * 2 * NCH * 16 * 64 * 2 * 4);
constexpr size_t WS_TOKW = al256(WS_TOKE + (size_t)T * 2 * 4);
constexpr size_t WS_LIST = al256(WS_TOKW + (size_t)T * 2 * 4);
constexpr size_t WS_HID = al256(WS_LIST + (size_t)32 * T * 4);
constexpr size_t WS_Y = al256(WS_HID + (size_t)T * 2 * 256 * 2);
constexpr size_t WS_WIN = al256(WS_Y + (size_t)T * 2 * D * 2);
constexpr size_t WS_WOUT = al256(WS_WIN + (size_t)PC * D * 2);
constexpr size_t WS_WGU = al256(WS_WOUT + (size_t)D * D * 2);
constexpr size_t WS_WD = al256(WS_WGU + (size_t)32 * 512 * D * 2);
constexpr size_t WS_WGLU = al256(WS_WD + (size_t)32 * D * 256 * 2);
constexpr size_t WS_WKV = al256(WS_WGLU + (size_t)256 * 256 * 2);
constexpr size_t WS_END = al256(WS_WKV + (size_t)512 * 128 * 2);

constexpr int LDS_BYTES = 150 * 1024;

struct Params {
    const float* in[45];
    float* out;
    unsigned char* ws;
    int lay_lo, lay_hi, ph_lo, ph_hi;
    int use_bar, pad0;
    int rep_ph, pad1;
};
enum { I_X = 0, I_C, I_CTX, I_CCTX, I_WADA, I_BADA, I_NORM1, I_NORM2, I_WIN, I_WOUT, I_MKVN, I_MWUK, I_MWUV, I_MQN, I_MKN,
       I_SCW, I_SCB, I_SALOG, I_SDTB, I_SD, I_SNORM, I_5LRE, I_5LIM, I_5LS, I_5BRE, I_5BIM, I_5CRE, I_5CIM, I_5D, I_5WGLU, I_5BGLU,
       I_DQN, I_DKN, I_DLQ1, I_DLK1, I_DLQ2, I_DLK2, I_DSUB, I_MWG, I_MBG, I_MWE, I_MBE, I_MWGATE, I_MWUP, I_MWDOWN };

DI int opq_tid() { int t = threadIdx.x; asm volatile("" : "+v"(t)); return t; }
typedef __attribute__((address_space(1))) unsigned char gch_t;
typedef __attribute__((address_space(1))) const float gcf_t;
DI unsigned char* opq_ws(const Params& P) { unsigned long long w = (unsigned long long)P.ws; asm volatile("" : "+s"(w)); return (unsigned char*)(gch_t*)w; }
DI const float* pin(const Params& P, int i) { asm volatile("" : "+s"(i)); return (const float*)(gcf_t*)(unsigned long long)P.in[i]; }
DI float bf2f(u16 v) { return __uint_as_float(((unsigned)v) << 16); }
DI unsigned pack_bf2(float a, float b) { f2_t f = {a, b}; bf2_t r = __builtin_convertvector(f, bf2_t); return __builtin_bit_cast(unsigned, r); }
DI u16 f2bf(float a) { return (u16)(pack_bf2(a, 0.f) & 0xffffu); }
DI float bflo(unsigned w) { return __uint_as_float(w << 16); }
DI float bfhi(unsigned w) { return __uint_as_float(w & 0xffff0000u); }
DI int crow(int reg, int h) { return (reg & 3) + 8 * (reg >> 2) + 4 * h; }
DI int kpos(int t) { return (t & ~12) | ((t & 4) << 1) | ((t & 8) >> 1); }
DI float wave_sum(float v) {
#pragma unroll
    for (int o = 32; o >= 1; o >>= 1) v += __shfl_xor(v, o, 64);
    return v;
}
DI float silu_f(float x) { return x / (1.f + __expf(-x)); }
DI f32x16 zero16() { f32x16 z;
#pragma unroll
    for (int i = 0; i < 16; ++i) z[i] = 0.f; return z; }
DI bf16x8 ld_frag(const unsigned char* p) { return *(const bf16x8*)p; }
DI int xcd_unit(int k) {
    if (gridDim.x == 256) return ((k * 8 + (int)(blockIdx.x & 7)) << 5) + (int)(blockIdx.x >> 3);
    return (int)blockIdx.x + k * (int)gridDim.x;
}
DI int chunk_at(int dir, int k) { return dir == 0 ? k : (k < 2 ? 1 - k : (NCH + 1) - k); }

#define XB_TMO      128
#define XB_XCNT(j)  (256  + 64 * (j))
#define XB_XSUB(j)  (1280 + 64 * (j))
#define XB_XGEN(j)  (2304 + 64 * (j))
#define XB_TOP      3328
#define XB_TOPGEN   3392
#define XCD_BAR_WORDS 3456
#define XB_SPIN_CAP (1u << 20)
#define LAS __attribute__((address_space(3)))

DI unsigned xb_ld(unsigned* p)              { return __hip_atomic_load(p, __ATOMIC_RELAXED, __HIP_MEMORY_SCOPE_AGENT); }
DI unsigned xb_add(unsigned* p, unsigned v) { return __hip_atomic_fetch_add(p, v, __ATOMIC_RELAXED, __HIP_MEMORY_SCOPE_AGENT); }
DI unsigned xb_xcc_id() { return (unsigned)__builtin_amdgcn_s_getreg((3 << 11) | 20) & 0xFu; }
#define XB_SPIN(cond, bar) do { unsigned _sp = 0; while (cond) { __builtin_amdgcn_s_sleep(1); \
    if ((++_sp & 255u) == 0u) { if (xb_ld(&(bar)[XB_TMO])) break; if (_sp > XB_SPIN_CAP) { atomicAdd(&(bar)[XB_TMO], 1u); break; } } } } while (0)

struct XcdBarrier { unsigned* bar; unsigned x; volatile LAS unsigned* st; };

DI XcdBarrier xcd_barrier_post(unsigned* bar, volatile LAS unsigned* st) {
    XcdBarrier b; b.bar = bar; b.x = xb_xcc_id(); b.st = st;
    if (threadIdx.x == 0) (void)xb_add(&bar[XB_XCNT(b.x)], 1u);
    return b;
}
DI void xcd_barrier_complete(unsigned* bar, unsigned x, unsigned& nloc, unsigned& nx) {
    const unsigned G = gridDim.x * gridDim.y * gridDim.z;
    unsigned sum, cnt, mine, sp = 0u;
    for (;;) {
        sum = 0u; cnt = 0u; mine = 0u;
#pragma unroll
        for (unsigned j = 0; j < 16; ++j) { const unsigned c = xb_ld(&bar[XB_XCNT(j)]); sum += c; cnt += (c > 0u) ? 1u : 0u; mine = (j == x) ? c : mine; }
        if (sum == G) break;
        __builtin_amdgcn_s_sleep(1);
        if ((++sp & 255u) == 0u) { if (xb_ld(&bar[XB_TMO])) break; if (sp > XB_SPIN_CAP) { atomicAdd(&bar[XB_TMO], 1u); break; } }
    }
    nloc = mine > 0u ? mine : 1u; nx = cnt > 0u ? cnt : 1u;
}
DI void xcd_barrier(const XcdBarrier& b) {
    asm volatile("s_waitcnt vmcnt(0)" ::: "memory");
    __syncthreads();
    if (threadIdx.x == 0) {
        unsigned* bar = b.bar;
        __builtin_amdgcn_s_waitcnt(0);
        unsigned nloc = b.st[0], nx = b.st[1];
        if (nloc == 0u) { xcd_barrier_complete(bar, b.x, nloc, nx); b.st[0] = nloc; b.st[1] = nx; }
        const unsigned old = xb_add(&bar[XB_XSUB(b.x)], 1u);
        const unsigned gen = old / nloc;
        if (old + 1u == (gen + 1u) * nloc) {
            __builtin_amdgcn_fence(__ATOMIC_RELEASE, "agent");
            asm volatile("s_waitcnt vmcnt(0)" ::: "memory");
            const unsigned og = xb_add(&bar[XB_TOP], 1u);
            const unsigned tg = og / nx;
            if (og + 1u == (tg + 1u) * nx) xb_add(&bar[XB_TOPGEN], 1u);
            else XB_SPIN(xb_ld(&bar[XB_TOPGEN]) == tg, bar);
            __builtin_amdgcn_fence(__ATOMIC_ACQUIRE, "agent");
            xb_add(&bar[XB_XGEN(b.x)], 1u);
            asm volatile("s_waitcnt vmcnt(0)" ::: "memory");
        } else {
            XB_SPIN(xb_ld(&bar[XB_XGEN(b.x)]) == gen, bar);
            __builtin_amdgcn_fence(__ATOMIC_ACQUIRE, "agent");
            asm volatile("s_waitcnt vmcnt(0)" ::: "memory");
        }
    }
    __syncthreads();
}

constexpr int LDT = 144;
template <int WGM, int WGN, int WM, int WN, class ARow, class Epi>
DI void gemm_tile(unsigned char* smem, ARow arow, const u16* __restrict__ Bt, int ldb, int n0, int K, Epi epi) {
    constexpr int BM = WGM * WM * 32, BN = WGN * WN * 32;
    constexpr int A_BYTES = BM * LDT, B_BYTES = BN * LDT, STAGE = A_BYTES + B_BYTES;
    constexpr int NA = BM * 8 / NTHR, NBc = BN * 8 / NTHR;
    static_assert(2 * STAGE <= LDS_BYTES, "gemm tile LDS");
    const int tid = opq_tid(), lane = tid & 63, wave = tid >> 6;
    const int wr = wave / WGN, wc = wave % WGN;
    const int lr = lane & 31, lh = lane >> 5;
    const uint4* ap[NA]; const uint4* bp[NBc];
#pragma unroll
    for (int i = 0; i < NA; ++i) ap[i] = (const uint4*)arow((tid >> 3) + 64 * i) + (tid & 7);
#pragma unroll
    for (int i = 0; i < NBc; ++i) bp[i] = (const uint4*)(Bt + (size_t)(n0 + (tid >> 3) + 64 * i) * ldb) + (tid & 7);
    const int woff = (tid >> 3) * LDT + (tid & 7) * 16;
    static_assert(NA == 2 || NA == 4, "NA"); static_assert(NBc == 2, "NBc");
    uint4 a0_0, a0_1, a0_2 = make_uint4(0, 0, 0, 0), a0_3 = make_uint4(0, 0, 0, 0), b0_0, b0_1;
    uint4 a1_0, a1_1, a1_2 = make_uint4(0, 0, 0, 0), a1_3 = make_uint4(0, 0, 0, 0), b1_0, b1_1;
#define GEMM_LOAD(S, t) do { a##S##_0 = ap[0][t]; a##S##_1 = ap[1][t]; if constexpr (NA == 4) { a##S##_2 = ap[2][t]; a##S##_3 = ap[3][t]; } \
        b##S##_0 = bp[0][t]; b##S##_1 = bp[1][t]; } while (0)
#define GEMM_STORE(S, base) do { *(uint4*)((base) + woff) = a##S##_0; *(uint4*)((base) + woff + 64 * LDT) = a##S##_1; \
        if constexpr (NA == 4) { *(uint4*)((base) + woff + 128 * LDT) = a##S##_2; *(uint4*)((base) + woff + 192 * LDT) = a##S##_3; } \
        *(uint4*)((base) + A_BYTES + woff) = b##S##_0; *(uint4*)((base) + A_BYTES + woff + 64 * LDT) = b##S##_1; } while (0)
    GEMM_LOAD(0, 0);
    GEMM_LOAD(1, 8);
    GEMM_STORE(0, smem);
    __syncthreads();
    f32x16 acc[WM][WN];
#pragma unroll
    for (int mi = 0; mi < WM; ++mi)
#pragma unroll
        for (int ni = 0; ni < WN; ++ni) acc[mi][ni] = zero16();
    const int nk = K / 64;
    const int a_rd = (wr * WM * 32 + lr) * LDT + lh * 16;
    const int b_rd = A_BYTES + (wc * WN * 32 + lr) * LDT + lh * 16;
#define GEMM_COMPUTE(st) do { \
        _Pragma("unroll") for (int s = 0; s < 4; ++s) { \
            bf16x8 a[WM], b[WN]; \
            _Pragma("unroll") for (int mi = 0; mi < WM; ++mi) a[mi] = ld_frag((st) + a_rd + mi * 32 * LDT + s * 32); \
            _Pragma("unroll") for (int ni = 0; ni < WN; ++ni) b[ni] = ld_frag((st) + b_rd + ni * 32 * LDT + s * 32); \
            __builtin_amdgcn_s_setprio(1); \
            _Pragma("unroll") for (int mi = 0; mi < WM; ++mi) \
                _Pragma("unroll") for (int ni = 0; ni < WN; ++ni) acc[mi][ni] = MFMA32(a[mi], b[ni], acc[mi][ni]); \
            __builtin_amdgcn_s_setprio(0); \
        } } while (0)
    for (int kt = 0; kt < nk; kt += 2) {
        const int t2 = min(kt + 2, nk - 1) * 8, t3 = min(kt + 3, nk - 1) * 8;
        GEMM_LOAD(0, t2);
        GEMM_COMPUTE(smem);
        GEMM_STORE(1, smem + STAGE);
        __syncthreads();
        GEMM_LOAD(1, t3);
        GEMM_COMPUTE(smem + STAGE);
        GEMM_STORE(0, smem);
        __syncthreads();
    }
    epi(acc, wr * WM * 32, wc * WN * 32, smem + wave * 9216);
    __syncthreads();
}

struct TileDesc {
    const u16* a; int lda;
    const int* gl; int ashift, nrow;
    const u16* b; int ldb;
    int u0, u1, u2, u3;
};
DI const u16* tile_arow(const TileDesc& d, int r) {
    return d.gl ? d.a + (size_t)(d.gl[min(r, d.nrow - 1)] >> d.ashift) * d.lda : d.a + (size_t)r * d.lda;
}
template <int WGM, int WGN, int WM, int WN, class Next, class Pre, class Epi>
DI void gemm_stream(unsigned char* smem, int K, Next next, Pre pre, Epi epi) {
    constexpr int BM = WGM * WM * 32, BN = WGN * WN * 32;
    constexpr int A_BYTES = BM * LDT, B_BYTES = BN * LDT, STAGE = A_BYTES + B_BYTES;
    constexpr int NA = BM * 8 / NTHR, NBc = BN * 8 / NTHR;
    constexpr int OB_BYTES = 9216 <= (LDS_BYTES - 2 * STAGE - 2048) / NWAVE ? 9216 : 4608;
    constexpr int TAB_OFF = 2 * STAGE + NWAVE * OB_BYTES;
    static_assert(TAB_OFF + 2048 <= LDS_BYTES, "tables");
    static_assert(NA == 2 || NA == 4, "NA"); static_assert(NBc == 2, "NBc");
    static_assert(OB_BYTES >= 4608, "staging");
    const int tid = opq_tid(), lane = tid & 63, wave = tid >> 6;
    const int wr = wave / WGN, wc = wave % WGN;
    const int lr = lane & 31, lh = lane >> 5;
    const int woff = (tid >> 3) * LDT + (tid & 7) * 16;
    const int a_rd = (wr * WM * 32 + lr) * LDT + lh * 16;
    const int b_rd = A_BYTES + (wc * WN * 32 + lr) * LDT + lh * 16;
    const int nk = K / 64;
    TileDesc cur, nxt;
    if (!next(0, cur)) return;
    const uint4* ap[NA]; const uint4* bp[NBc]; const uint4* apn[NA]; const uint4* bpn[NBc];
#pragma unroll
    for (int i = 0; i < NA; ++i) ap[i] = (const uint4*)tile_arow(cur, (tid >> 3) + 64 * i) + (tid & 7);
#pragma unroll
    for (int i = 0; i < NBc; ++i) bp[i] = (const uint4*)(cur.b + (size_t)((tid >> 3) + 64 * i) * cur.ldb) + (tid & 7);
    uint4 a0_0, a0_1, a0_2 = make_uint4(0, 0, 0, 0), a0_3 = make_uint4(0, 0, 0, 0), b0_0, b0_1;
    uint4 a1_0, a1_1, a1_2 = make_uint4(0, 0, 0, 0), a1_3 = make_uint4(0, 0, 0, 0), b1_0, b1_1;
#define GS_LOAD(S, AP, BP, t) do { a##S##_0 = AP[0][t]; a##S##_1 = AP[1][t]; if constexpr (NA == 4) { a##S##_2 = AP[2][t]; a##S##_3 = AP[3][t]; } \
        b##S##_0 = BP[0][t]; b##S##_1 = BP[1][t]; } while (0)
    GS_LOAD(0, ap, bp, 0);
    GS_LOAD(1, ap, bp, 8);
    GEMM_STORE(0, smem);
    __syncthreads();
    bool have = true;
    for (int k = 0; have; ++k) {
        const bool hn = next(k + 1, nxt);
        if (hn) {
#pragma unroll
            for (int i = 0; i < NA; ++i) apn[i] = (const uint4*)tile_arow(nxt, (tid >> 3) + 64 * i) + (tid & 7);
#pragma unroll
            for (int i = 0; i < NBc; ++i) bpn[i] = (const uint4*)(nxt.b + (size_t)((tid >> 3) + 64 * i) * nxt.ldb) + (tid & 7);
        } else {
#pragma unroll
            for (int i = 0; i < NA; ++i) apn[i] = ap[i];
#pragma unroll
            for (int i = 0; i < NBc; ++i) bpn[i] = bp[i];
        }
        f32x16 acc[WM][WN];
#pragma unroll
        for (int mi = 0; mi < WM; ++mi)
#pragma unroll
            for (int ni = 0; ni < WN; ++ni) acc[mi][ni] = zero16();
        pre(cur, 0, smem + TAB_OFF);
        for (int kt = 0; kt < nk; kt += 2) {
            const bool last = kt + 2 >= nk;
            if (kt == 2 || (nk == 2 && kt == 0)) pre(cur, 1, smem + TAB_OFF);
            if (!last) GS_LOAD(0, ap, bp, (kt + 2) * 8); else GS_LOAD(0, apn, bpn, 0);
            GEMM_COMPUTE(smem);
            GEMM_STORE(1, smem + STAGE);
            __syncthreads();
            if (!last) GS_LOAD(1, ap, bp, (kt + 3) * 8); else GS_LOAD(1, apn, bpn, 8);
            GEMM_COMPUTE(smem + STAGE);
            GEMM_STORE(0, smem);
            __syncthreads();
        }
        epi(cur, acc, wr * WM * 32, wc * WN * 32, smem + 2 * STAGE + wave * OB_BYTES, smem + TAB_OFF);
        cur = nxt; have = hn;
#pragma unroll
        for (int i = 0; i < NA; ++i) ap[i] = apn[i];
#pragma unroll
        for (int i = 0; i < NBc; ++i) bp[i] = bpn[i];
    }
#undef GS_LOAD
}

template <int WGM, int WGN, int WM, int WN, class ARow, class Epi>
DI void gemm_tile_dma(unsigned char* smem, ARow arow, const u16* __restrict__ Bt, int ldb, int n0, int K, Epi epi) {
    constexpr int BM = WGM * WM * 32, BN = WGN * WN * 32;
    constexpr int A_BYTES = BM * 128, STAGE = (BM + BN) * 128;
    constexpr int NA = BM / 64, NBc = BN / 64, NOPS = NA + NBc;
    static_assert(3 * STAGE <= LDS_BYTES, "gemm dma LDS");
    const int tid = opq_tid(), lane = tid & 63, wave = __builtin_amdgcn_readfirstlane(tid >> 6);
    const int wr = wave / WGN, wc = wave % WGN;
    const int lr = lane & 31, lh = lane >> 5;
    const int rin = wave * 8 + (lane >> 3);
    const int csrc = ((lane & 7) ^ ((rin >> 1) & 7)) * 8;
    const u16* ap[NA]; const u16* bp[NBc];
#pragma unroll
    for (int i = 0; i < NA; ++i) ap[i] = arow(i * 64 + rin) + csrc;
#pragma unroll
    for (int i = 0; i < NBc; ++i) bp[i] = Bt + (size_t)(n0 + i * 64 + rin) * ldb + csrc;
    unsigned char* wbase = smem + wave * 1024;
#define GEMM_DMA_ISSUE(kt_, st_) do { unsigned char* sbase = wbase + (st_) * STAGE; \
        _Pragma("unroll") for (int i = 0; i < NA; ++i) __builtin_amdgcn_global_load_lds((const unsigned*)(ap[i] + (kt_) * 64), (unsigned*)(sbase + i * 8192), 16, 0, 0); \
        _Pragma("unroll") for (int i = 0; i < NBc; ++i) __builtin_amdgcn_global_load_lds((const unsigned*)(bp[i] + (kt_) * 64), (unsigned*)(sbase + A_BYTES + i * 8192), 16, 0, 0); } while (0)
    const int nk = K / 64;
    GEMM_DMA_ISSUE(0, 0);
    GEMM_DMA_ISSUE(1, 1);
    f32x16 acc[WM][WN];
#pragma unroll
    for (int mi = 0; mi < WM; ++mi)
#pragma unroll
        for (int ni = 0; ni < WN; ++ni) acc[mi][ni] = zero16();
    const int swz = (lr >> 1) & 7;
    const int a_rd = (wr * WM * 32 + lr) * 128, b_rd = A_BYTES + (wc * WN * 32 + lr) * 128;
    int stg = 0;
    for (int kt = 0; kt < nk; ++kt) {
        if (kt + 1 < nk) asm volatile("s_waitcnt vmcnt(%0)" :: "n"(NOPS) : "memory");
        else             asm volatile("s_waitcnt vmcnt(0)" ::: "memory");
        __builtin_amdgcn_s_barrier();
        if (kt + 2 < nk) { const int s2 = (stg == 0) ? 2 : stg - 1; GEMM_DMA_ISSUE(kt + 2, s2); }
        const unsigned char* st = smem + stg * STAGE;
#pragma unroll
        for (int s = 0; s < 4; ++s) {
            const int co = ((2 * s + lh) ^ swz) * 16;
            bf16x8 a[WM], b[WN];
#pragma unroll
            for (int mi = 0; mi < WM; ++mi) a[mi] = ld_frag(st + a_rd + mi * 32 * 128 + co);
#pragma unroll
            for (int ni = 0; ni < WN; ++ni) b[ni] = ld_frag(st + b_rd + ni * 32 * 128 + co);
#pragma unroll
            for (int mi = 0; mi < WM; ++mi)
#pragma unroll
                for (int ni = 0; ni < WN; ++ni) acc[mi][ni] = MFMA32(a[mi], b[ni], acc[mi][ni]);
        }
        stg = (stg == 2) ? 0 : stg + 1;
    }
    __syncthreads();
    epi(acc, wr * WM * 32, wc * WN * 32, smem + wave * 9216);
    __syncthreads();
}

template <int WM, int WN, class Val, class Store>
DI void epi_bf16_rows(unsigned char* ob, int lane, Val val, Store store) {
    constexpr int C = WN * 32, R = WM * 32, PITCH = C * 2 + 16, CPR = C / 8, NCH = R * CPR;
    static_assert(R * PITCH <= 9216, "staging area");
    const int lr = lane & 31, lh = lane >> 5;
#pragma unroll
    for (int mi = 0; mi < WM; ++mi)
#pragma unroll
        for (int ni = 0; ni < WN; ++ni)
#pragma unroll
            for (int i = 0; i < 16; ++i) *(u16*)(ob + (mi * 32 + crow(i, lh)) * PITCH + (ni * 32 + lr) * 2) = f2bf(val(mi, ni, i));
    asm volatile("s_waitcnt lgkmcnt(0)" ::: "memory"); __builtin_amdgcn_wave_barrier();
#pragma unroll
    for (int it = 0; it < NCH / 64; ++it) {
        const int idx = it * 64 + lane, row = idx / CPR, ch = idx % CPR;
        store(row, ch * 8, *(const uint4*)(ob + row * PITCH + ch * 16));
    }
}

DI void ph_prologue(const Params& P, unsigned char* smem) {
    unsigned char* ws = opq_ws(P);
    const int tid = opq_tid();
    const size_t gtid = (size_t)blockIdx.x * NTHR + tid, gstr = (size_t)gridDim.x * NTHR;
    {
        float4* xb = (float4*)(ws + WS_X);
        const float4* xin = (const float4*)P.in[I_X]; const float4* cin = (const float4*)P.in[I_CTX];
        for (size_t i = gtid; i < (size_t)T * 256; i += gstr) {
            const int row = (int)(i >> 8), c4 = (int)(i & 255);
            const int b = row / LSEQ, u = row % LSEQ;
            xb[i] = (u < CTX) ? cin[((size_t)(b * CTX + u)) * 256 + c4] : xin[((size_t)(b * SEQ + u - CTX)) * 256 + c4];
        }
    }
    {
        float* sl = (float*)smem;
        float* red = sl + 3072;
        for (int i = tid; i < 3072; i += NTHR) {
            const int w = i >> 10, k = i & 1023;
            const float v = (w < 2) ? P.in[I_C][w * 1024 + k] : P.in[I_CCTX][k];
            sl[i] = v / (1.f + expf(-v));
        }
        __syncthreads();
        float* mods = (float*)(ws + WS_MODS);
        const int cg = tid & 15, ks = tid >> 4;
        for (int item = blockIdx.x; item < DEPTH * 96; item += gridDim.x) {
            const int l = item / 96, cb = item % 96;
            const float* wp = P.in[I_WADA] + ((size_t)l * 1024 + ks * 32) * 6144 + cb * 64 + cg * 4;
            float acc[3][4];
#pragma unroll
            for (int w = 0; w < 3; ++w)
#pragma unroll
                for (int j = 0; j < 4; ++j) acc[w][j] = 0.f;
#pragma unroll 8
            for (int kk = 0; kk < 32; ++kk) {
                const float4 wv = *(const float4*)(wp + (size_t)kk * 6144);
                const int k = ks * 32 + kk;
#pragma unroll
                for (int w = 0; w < 3; ++w) {
                    const float s = sl[w * 1024 + k];
                    acc[w][0] += s * wv.x; acc[w][1] += s * wv.y; acc[w][2] += s * wv.z; acc[w][3] += s * wv.w;
                }
            }
#pragma unroll
            for (int w = 0; w < 3; ++w)
#pragma unroll
                for (int j = 0; j < 4; ++j) red[(ks * 3 + w) * 64 + cg * 4 + j] = acc[w][j];
            __syncthreads();
            if (tid < 192) {
                const int w = tid >> 6, j = tid & 63;
                float s = P.in[I_BADA][l * 6144 + cb * 64 + j];
                for (int q = 0; q < 32; ++q) s += red[(q * 3 + w) * 64 + j];
                mods[((size_t)l * 3 + w) * 6144 + cb * 64 + j] = s;
            }
            __syncthreads();
        }
    }
    {
        float* s5a = (float*)(ws + WS_S5A); u16* bt = (u16*)(ws + WS_S5BT); u16* ct = (u16*)(ws + WS_S5CT);
        for (size_t idx = gtid; idx < (size_t)DEPTH * 2 * 16 * 64; idx += gstr) {
            const int p = (int)(idx & 63), g = (int)((idx >> 6) & 15), d = (int)((idx >> 10) & 1), l = (int)(idx >> 11);
            const float lr = P.in[I_5LRE][idx], li = P.in[I_5LIM][idx];
            const float step = expf(P.in[I_5LS][(l * 2 + d) * 16 + g]);
            const float er = expf(lr * step);
            const float ar = er * cosf(li * step), ai = er * sinf(li * step);
            const float nr = ar - 1.f, ni = ai, den = lr * lr + li * li;
            const float fr = (nr * lr + ni * li) / den, fi = (ni * lr - nr * li) / den;
            s5a[idx * 2] = ar; s5a[idx * 2 + 1] = ai;
            const size_t ldg = (size_t)(l * 2 + d) * 16 + g;
            const float* bre = P.in[I_5BRE] + (((size_t)l * 16 + g) * 64 + p) * 16;
            const float* bim = P.in[I_5BIM] + (((size_t)l * 16 + g) * 64 + p) * 16;
            for (int j = 0; j < 16; ++j) {
                const float br = fr * bre[j] - fi * bim[j], bi = fr * bim[j] + fi * bre[j];
                bt[(ldg * 128 + p) * 16 + j] = f2bf(br);
                bt[(ldg * 128 + 64 + p) * 16 + j] = f2bf(bi);
            }
            for (int jo = 0; jo < 16; ++jo) {
                const float cre = P.in[I_5CRE][(ldg * 16 + jo) * 64 + p], cim = P.in[I_5CIM][(ldg * 16 + jo) * 64 + p];
                ct[(ldg * 16 + jo) * 128 + 2 * p] = f2bf(cre);
                ct[(ldg * 16 + jo) * 128 + 2 * p + 1] = f2bf(-cim);
            }
        }
    }
}

DI void conv_tile64(float* tile, const float* __restrict__ src, int sstride, int R0, int C0, int Cvalid,
                    u16* __restrict__ dst, int dstride, int drow_base, int drow_hi) {
    const int tid = opq_tid();
#pragma unroll
    for (int it = 0; it < 2; ++it) {
        const int i = (tid >> 4) + 32 * it, j4 = (tid & 15) * 4;
        float4 v = make_float4(0.f, 0.f, 0.f, 0.f);
        if (C0 + j4 < Cvalid) v = *(const float4*)(src + (size_t)(R0 + i) * sstride + C0 + j4);
        float* tp = tile + i * 65 + j4;
        tp[0] = v.x; tp[1] = v.y; tp[2] = v.z; tp[3] = v.w;
    }
    __syncthreads();
    {
        const int j = tid >> 3, i8 = (tid & 7) * 8;
        uint4 o;
        o.x = pack_bf2(tile[(i8 + 0) * 65 + j], tile[(i8 + 1) * 65 + j]);
        o.y = pack_bf2(tile[(i8 + 2) * 65 + j], tile[(i8 + 3) * 65 + j]);
        o.z = pack_bf2(tile[(i8 + 4) * 65 + j], tile[(i8 + 5) * 65 + j]);
        o.w = pack_bf2(tile[(i8 + 6) * 65 + j], tile[(i8 + 7) * 65 + j]);
        const int drow = drow_base + (j >> 5) * drow_hi + (j & 31);
        *(uint4*)(dst + (size_t)drow * dstride + R0 + i8) = o;
    }
    __syncthreads();
}

DI void ph_norm1(const Params& P, int layer, unsigned char* smem, bool combine = true) {
    unsigned char* ws = opq_ws(P);
    const int tid = opq_tid(), lane = tid & 63, wave = tid >> 6;
    {
        float* xbuf = (float*)(ws + WS_X); u16* hn = (u16*)(ws + WS_HN); const u16* yb = (const u16*)(ws + WS_Y);
        const float* mods = (const float*)(ws + WS_MODS);
        const float* g1 = P.in[I_NORM1] + layer * 1024;
        float4 gv[4];
#pragma unroll
        for (int i = 0; i < 4; ++i) gv[i] = *(const float4*)(g1 + i * 256 + lane * 4);
        for (int row = blockIdx.x * NWAVE + wave; row < T; row += gridDim.x * NWAVE) {
            const int b = row / LSEQ, u = row % LSEQ, which = (u < CTX) ? 2 : b;
            float* xr = xbuf + (size_t)row * 1024;
            float4 v[4];
#pragma unroll
            for (int i = 0; i < 4; ++i) v[i] = *(const float4*)(xr + i * 256 + lane * 4);
            if (layer > 0 && combine) {
                const float* g2 = mods + ((size_t)(layer - 1) * 3 + which) * 6144 + 5 * 1024;
                const u16* y0 = yb + (size_t)(2 * row) * 1024; const u16* y1 = y0 + 1024;
#pragma unroll
                for (int i = 0; i < 4; ++i) {
                    const uint2 a = *(const uint2*)(y0 + i * 256 + lane * 4), c = *(const uint2*)(y1 + i * 256 + lane * 4);
                    const float4 gg = *(const float4*)(g2 + i * 256 + lane * 4);
                    v[i].x += gg.x * (bflo(a.x) + bflo(c.x)); v[i].y += gg.y * (bfhi(a.x) + bfhi(c.x));
                    v[i].z += gg.z * (bflo(a.y) + bflo(c.y)); v[i].w += gg.w * (bfhi(a.y) + bfhi(c.y));
                    *(float4*)(xr + i * 256 + lane * 4) = v[i];
                }
            }
            float ss = 0.f;
#pragma unroll
            for (int i = 0; i < 4; ++i) ss += v[i].x * v[i].x + v[i].y * v[i].y + v[i].z * v[i].z + v[i].w * v[i].w;
            ss = wave_sum(ss);
            const float rstd = rsqrtf(ss * (1.f / 1024.f) + EPS);
            const float* sh = mods + ((size_t)layer * 3 + which) * 6144; const float* sc = sh + 1024;
#pragma unroll
            for (int i = 0; i < 4; ++i) {
                const float4 s4 = *(const float4*)(sh + i * 256 + lane * 4), c4 = *(const float4*)(sc + i * 256 + lane * 4);
                uint2 o;
                o.x = pack_bf2(v[i].x * rstd * gv[i].x * (1.f + c4.x) + s4.x, v[i].y * rstd * gv[i].y * (1.f + c4.y) + s4.y);
                o.y = pack_bf2(v[i].z * rstd * gv[i].z * (1.f + c4.z) + s4.z, v[i].w * rstd * gv[i].w * (1.f + c4.w) + s4.w);
                *(uint2*)(hn + (size_t)row * 1024 + i * 256 + lane * 4) = o;
            }
        }
    }
    {
        float* tile = (float*)smem;
        constexpr int J0 = 16 * 38, J1 = J0 + 256, J2 = J1 + 2048, J3 = J2 + 2048, J4 = J3 + 2048, J5 = J4 + 16, J6 = J5 + 8, J7 = J6 + 8;
        struct CJ { const float* src; int sstride, R0, C0, Cvalid; u16* dst; int dstride, drow_base, drow_hi; };
        auto decode = [&](int it, CJ& j) {
            if (it < J0) { const int rt = it / 38, ctile = it % 38;
                j = CJ{P.in[I_WIN] + (size_t)layer * 1024 * IN_COLS, IN_COLS, rt * 64, ctile * 64, IN_COLS, (u16*)(ws + WS_WIN), 1024, ctile * 64, 32}; }
            else if (it < J1) { const int q = it - J0, rt = q >> 4, ctile = q & 15;
                j = CJ{P.in[I_WOUT] + (size_t)layer * 1024 * 1024, 1024, rt * 64, ctile * 64, 1024, (u16*)(ws + WS_WOUT), 1024, ctile * 64, 32}; }
            else if (it < J3) { const int up = it >= J2; const int q = it - (up ? J2 : J1); const int e = q >> 6, rt = (q >> 2) & 15, ctile = q & 3;
                j = CJ{P.in[up ? I_MWUP : I_MWGATE] + ((size_t)layer * 32 + e) * 1024 * 256, 256, rt * 64, ctile * 64, 256,
                       (u16*)(ws + WS_WGU) + (size_t)e * 512 * 1024, 1024, ctile * 128 + up * 32, 64}; }
            else if (it < J4) { const int q = it - J3, e = q >> 6, rt = (q >> 4) & 3, ctile = q & 15;
                j = CJ{P.in[I_MWDOWN] + ((size_t)layer * 32 + e) * 256 * 1024, 1024, rt * 64, ctile * 64, 1024,
                       (u16*)(ws + WS_WD) + (size_t)e * 1024 * 256, 256, ctile * 64, 32}; }
            else if (it < J5) { const int q = it - J4, rt = q >> 2, ctile = q & 3;
                j = CJ{P.in[I_5WGLU] + (size_t)layer * 256 * 256, 256, rt * 64, ctile * 64, 256, (u16*)(ws + WS_WGLU), 256, ctile * 64, 32}; }
            else { const int uv = it >= J6; const int q = it - (uv ? J6 : J5), rt = q >> 2, ctile = q & 3;
                j = CJ{P.in[uv ? I_MWUV : I_MWUK] + (size_t)layer * 128 * 256, 256, rt * 64, ctile * 64, 256, (u16*)(ws + WS_WKV), 128, uv * 256 + ctile * 64, 32}; }
        };
        static_assert(J7 % 4 == 0, "conversion tiles come in fours");
        for (int it4 = blockIdx.x * 4; it4 < J7; it4 += gridDim.x * 4) {
            float4 v[4][2];
#pragma unroll
            for (int q = 0; q < 4; ++q) {
                CJ j; decode(it4 + q, j);
#pragma unroll
                for (int h = 0; h < 2; ++h) {
                    const int i = (tid >> 4) + 32 * h, j4 = (tid & 15) * 4;
                    v[q][h] = make_float4(0.f, 0.f, 0.f, 0.f);
                    if (j.C0 + j4 < j.Cvalid) v[q][h] = *(const float4*)(j.src + (size_t)(j.R0 + i) * j.sstride + j.C0 + j4);
                }
            }
#pragma unroll
            for (int q = 0; q < 4; ++q)
#pragma unroll
                for (int h = 0; h < 2; ++h) {
                    const int i = (tid >> 4) + 32 * h, j4 = (tid & 15) * 4;
                    float* tp = tile + q * 4160 + i * 65 + j4;
                    tp[0] = v[q][h].x; tp[1] = v[q][h].y; tp[2] = v[q][h].z; tp[3] = v[q][h].w;
                }
            __syncthreads();
#pragma unroll
            for (int q = 0; q < 4; ++q) {
                CJ j; decode(it4 + q, j);
                const float* tq = tile + q * 4160;
                const int jj = tid >> 3, i8 = (tid & 7) * 8;
                uint4 o;
                o.x = pack_bf2(tq[(i8 + 0) * 65 + jj], tq[(i8 + 1) * 65 + jj]);
                o.y = pack_bf2(tq[(i8 + 2) * 65 + jj], tq[(i8 + 3) * 65 + jj]);
                o.z = pack_bf2(tq[(i8 + 4) * 65 + jj], tq[(i8 + 5) * 65 + jj]);
                o.w = pack_bf2(tq[(i8 + 6) * 65 + jj], tq[(i8 + 7) * 65 + jj]);
                const int drow = j.drow_base + (jj >> 5) * j.drow_hi + (jj & 31);
                *(uint4*)(j.dst + (size_t)drow * j.dstride + j.R0 + i8) = o;
            }
            __syncthreads();
        }
    }
}

DI void ph_gemm_in(const Params& P, unsigned char* smem) {
    unsigned char* ws = opq_ws(P);
    const u16* hn = (const u16*)(ws + WS_HN); const u16* wt = (const u16*)(ws + WS_WIN); u16* pb = (u16*)(ws + WS_P);
    const int lane = opq_tid() & 63;
    constexpr int NT = PC / 128, MT = T / 256;
    gemm_stream<4, 2, 2, 2>(smem, 1024,
        [&](int k, TileDesc& d) {
            const int o = xcd_unit(k);
            if (o >= MT * NT) return false;
            int mt, nt;
            if (o < 64 * NT) { const int g = o / (8 * NT), rem = o % (8 * NT); nt = rem >> 3; mt = g * 8 + (rem & 7); }
            else { const int q = o - 64 * NT; nt = q >> 1; mt = 64 + (q & 1); }
            d.a = hn + (size_t)mt * 256 * 1024; d.lda = 1024; d.gl = nullptr; d.ashift = 0; d.nrow = 256;
            d.b = wt + (size_t)nt * 128 * 1024; d.ldb = 1024; d.u0 = mt * 256; d.u1 = nt * 128; d.u2 = 0; d.u3 = 0;
            return true;
        },
        [&](const TileDesc&, int, unsigned char*) {},
        [&](const TileDesc& d, f32x16 (&acc)[2][2], int r0, int c0, unsigned char* ob, unsigned char*) {
#pragma unroll
            for (int mi = 0; mi < 2; ++mi)
                epi_bf16_rows<1, 2>(ob, lane, [&](int, int ni, int i) { return acc[mi][ni][i]; },
                    [&](int row, int col, const uint4& v) { *(uint4*)(pb + (size_t)(d.u0 + r0 + mi * 32 + row) * PC + d.u1 + c0 + col) = v; });
        });
}

constexpr int LDS_TAB = 136 * 1024;
constexpr int LDS_GAIN = LDS_TAB + 8192;
DI float fma_asm(float a, float b, float c) { float d; asm("v_fma_f32 %0, %1, %2, %3" : "=v"(d) : "v"(a), "v"(b), "v"(c)); return d; }
DI void wave_lds_fence() { asm volatile("s_waitcnt lgkmcnt(0)" ::: "memory"); __builtin_amdgcn_wave_barrier(); }

DI void unpack8(const uint4& r, float* x) {
    x[0] = bflo(r.x); x[1] = bfhi(r.x); x[2] = bflo(r.y); x[3] = bfhi(r.y); x[4] = bflo(r.z); x[5] = bfhi(r.z); x[6] = bflo(r.w); x[7] = bfhi(r.w);
}
DI uint4 pack8(const float* x) { uint4 o; o.x = pack_bf2(x[0], x[1]); o.y = pack_bf2(x[2], x[3]); o.z = pack_bf2(x[4], x[5]); o.w = pack_bf2(x[6], x[7]); return o; }
DI void rope32(float* t, const float* cs, int gr, int gc) {
#pragma unroll
    for (int i = 0; i < 8; ++i) {
        const float c = cs[(gr * 8 + i) * 2], s = cs[(gr * 8 + i) * 2 + 1];
        const float a = t[i], b = t[8 + i]; t[i] = a * c - b * s; t[8 + i] = a * s + b * c;
        const float c2 = cs[(gc * 8 + i) * 2], s2 = cs[(gc * 8 + i) * 2 + 1];
        const float a2 = t[16 + i], b2 = t[24 + i]; t[16 + i] = a2 * c2 - b2 * s2; t[24 + i] = a2 * s2 + b2 * c2;
    }
}
DI void rope16(float* t, const float* cs, int pos) {
#pragma unroll
    for (int i = 0; i < 8; ++i) {
        const float c = cs[(pos * 8 + i) * 2], s = cs[(pos * 8 + i) * 2 + 1];
        const float a = t[i], b = t[8 + i]; t[i] = a * c - b * s; t[8 + i] = a * s + b * c;
    }
}

DI void mla_prep_item(const Params& P, int item, unsigned char* smem) {
    unsigned char* ws = opq_ws(P);
    const float* cs = (const float*)(smem + LDS_TAB); const float* gn = (const float*)(smem + LDS_GAIN);
    const float* qn = gn; const float* kn = gn + 96; const float* kvn = gn + 192;
    const int tid = opq_tid(), lane = tid & 63, wave = tid >> 6, r = lane & 31, hh = lane >> 5;
    const int row = item * 256 + wave * 32 + r;
    const int b = row / LSEQ, u = row % LSEQ; const bool lat = u >= CTX; const int l = lat ? u - CTX : 0; const int gr = l >> 6, gc = l & 63;
    const u16* pr = (const u16*)(ws + WS_P) + (size_t)row * PC;
    u16* Qm = (u16*)(ws + WS_QM); u16* Km = (u16*)(ws + WS_KM); u16* Vt = (u16*)(ws + WS_VTM);
    const u16* wkv = (const u16*)(ws + WS_WKV);
    const float qscale = 1.472444460e-01f;
#pragma unroll 1
    for (int hq = 0; hq < 2; ++hq) {
        const int head = 2 * hh + hq;
        uint4 raw[12]; float ss = 0.f;
#pragma unroll
        for (int i = 0; i < 12; ++i) raw[i] = *(const uint4*)(pr + C_MQ + head * 96 + i * 8);
#pragma unroll
        for (int i = 0; i < 12; ++i) { float x[8]; unpack8(raw[i], x);
#pragma unroll
            for (int j = 0; j < 8; ++j) ss += x[j] * x[j]; }
        const float rstd = rsqrtf(ss * (1.f / 96.f) + EPS);
        u16* qo = Qm + ((size_t)(b * 4 + head) * LSEQ + u) * 96;
#pragma unroll
        for (int i = 0; i < 8; ++i) { float x[8]; unpack8(raw[i], x);
#pragma unroll
            for (int j = 0; j < 8; ++j) x[j] = x[j] * rstd * qn[i * 8 + j] * qscale;
            *(uint4*)(qo + i * 8) = pack8(x); }
        float t[32];
#pragma unroll
        for (int i = 0; i < 4; ++i) { float x[8]; unpack8(raw[8 + i], x);
#pragma unroll
            for (int j = 0; j < 8; ++j) t[i * 8 + j] = x[j] * rstd * qn[64 + i * 8 + j]; }
        if (lat) rope32(t, cs, gr, gc);
#pragma unroll
        for (int i = 0; i < 32; ++i) t[i] *= qscale;
#pragma unroll
        for (int i = 0; i < 4; ++i) *(uint4*)(qo + 64 + i * 8) = pack8(t + i * 8);
    }
    bf16x8 cf[8];
    {
        uint4 raw[8]; float ss = 0.f;
#pragma unroll
        for (int s = 0; s < 8; ++s) { raw[s] = *(const uint4*)(pr + C_MCKV + 16 * s + 8 * hh); float x[8]; unpack8(raw[s], x);
#pragma unroll
            for (int j = 0; j < 8; ++j) ss += x[j] * x[j]; }
        ss += __shfl_xor(ss, 32, 64);
        const float rstd = rsqrtf(ss * (1.f / 128.f) + EPS);
#pragma unroll
        for (int s = 0; s < 8; ++s) { float x[8]; unpack8(raw[s], x);
#pragma unroll
            for (int j = 0; j < 8; ++j) x[j] = x[j] * rstd * kvn[16 * s + 8 * hh + j];
            const uint4 pk = pack8(x); cf[s] = __builtin_bit_cast(bf16x8, pk); }
    }
    float kr[16]; float ssr = 0.f;
    {
        const uint4 r0 = *(const uint4*)(pr + C_MKR + 16 * hh), r1 = *(const uint4*)(pr + C_MKR + 16 * hh + 8);
        unpack8(r0, kr); unpack8(r1, kr + 8);
#pragma unroll
        for (int j = 0; j < 16; ++j) ssr += kr[j] * kr[j];
        ssr += __shfl_xor(ssr, 32, 64);
    }
#pragma unroll 1
    for (int hd = 0; hd < 4; ++hd) {
        f32x16 k0 = zero16(), k1 = zero16();
#pragma unroll
        for (int s = 0; s < 8; ++s) {
            const bf16x8 a0 = *(const bf16x8*)(wkv + (size_t)(hd * 64 + r) * 128 + 16 * s + 8 * hh);
            const bf16x8 a1 = *(const bf16x8*)(wkv + (size_t)(hd * 64 + 32 + r) * 128 + 16 * s + 8 * hh);
            k0 = MFMA32(a0, cf[s], k0); k1 = MFMA32(a1, cf[s], k1);
        }
        float ssk = 0.f;
#pragma unroll
        for (int i = 0; i < 16; ++i) ssk += k0[i] * k0[i] + k1[i] * k1[i];
        ssk += __shfl_xor(ssk, 32, 64);
        const float rstd = rsqrtf((ssk + ssr) * (1.f / 96.f) + EPS);
        u16* ko = Km + ((size_t)(b * 4 + hd) * LSEQ + u) * 96;
#pragma unroll
        for (int q4 = 0; q4 < 4; ++q4) {
            const int d0 = 8 * q4 + 4 * hh;
            uint2 o;
            o.x = pack_bf2(k0[4 * q4] * rstd * kn[d0], k0[4 * q4 + 1] * rstd * kn[d0 + 1]);
            o.y = pack_bf2(k0[4 * q4 + 2] * rstd * kn[d0 + 2], k0[4 * q4 + 3] * rstd * kn[d0 + 3]);
            *(uint2*)(ko + d0) = o;
            o.x = pack_bf2(k1[4 * q4] * rstd * kn[32 + d0], k1[4 * q4 + 1] * rstd * kn[32 + d0 + 1]);
            o.y = pack_bf2(k1[4 * q4 + 2] * rstd * kn[32 + d0 + 2], k1[4 * q4 + 3] * rstd * kn[32 + d0 + 3]);
            *(uint2*)(ko + 32 + d0) = o;
        }
        {
            float t[16];
#pragma unroll
            for (int j = 0; j < 16; ++j) t[j] = kr[j] * rstd * kn[64 + 16 * hh + j];
            if (lat) rope16(t, cs, hh ? gc : gr);
            *(uint4*)(ko + 64 + 16 * hh) = pack8(t); *(uint4*)(ko + 64 + 16 * hh + 8) = pack8(t + 8);
        }
        f32x16 v0 = zero16(), v1 = zero16();
#pragma unroll
        for (int s = 0; s < 8; ++s) {
            const bf16x8 a2 = *(const bf16x8*)(wkv + (size_t)(256 + hd * 64 + r) * 128 + 16 * s + 8 * hh);
            const bf16x8 a3 = *(const bf16x8*)(wkv + (size_t)(256 + hd * 64 + 32 + r) * 128 + 16 * s + 8 * hh);
            v0 = MFMA32(a2, cf[s], v0); v1 = MFMA32(a3, cf[s], v1);
        }
        u16* vo = Vt + ((size_t)(b * 4 + hd) * 64) * LSEQ + kpos(u);
#pragma unroll
        for (int i = 0; i < 16; ++i) {
            vo[(size_t)crow(i, hh) * LSEQ] = f2bf(v0[i]);
            vo[(size_t)(32 + crow(i, hh)) * LSEQ] = f2bf(v1[i]);
        }
    }
}

DI void diff_prep_item(const Params& P, int item, unsigned char* smem) {
    unsigned char* ws = opq_ws(P);
    const float* cs = (const float*)(smem + LDS_TAB); const float* gn = (const float*)(smem + LDS_GAIN);
    const int tid = opq_tid(), tokl = tid & 255, part = tid >> 8;
    const int row = item * 256 + tokl;
    const int b = row / LSEQ, u = row % LSEQ; const bool lat = u >= CTX; const int l = lat ? u - CTX : 0; const int gr = l >> 6, gc = l & 63;
    const u16* pr = (const u16*)(ws + WS_P) + (size_t)row * PC;
    {
        const float* g = gn + 320 + part * 32;
        const float scale = part ? 1.f : 2.550348616e-01f;
        const u16* src = pr + (part ? C_DK : C_DQ);
        u16* dst = (u16*)(ws + (part ? WS_KD : WS_QD));
#pragma unroll 2
        for (int head = 0; head < 8; ++head) {
            float t[32]; float ss = 0.f;
#pragma unroll
            for (int i = 0; i < 4; ++i) { const uint4 rr = *(const uint4*)(src + head * 32 + i * 8); unpack8(rr, t + i * 8); }
#pragma unroll
            for (int i = 0; i < 32; ++i) ss += t[i] * t[i];
            const float rstd = rsqrtf(ss * (1.f / 32.f) + EPS);
#pragma unroll
            for (int i = 0; i < 32; ++i) t[i] = t[i] * rstd * g[i];
            if (lat) rope32(t, cs, gr, gc);
#pragma unroll
            for (int i = 0; i < 32; ++i) t[i] *= scale;
            u16* o = dst + ((size_t)(b * 4 + (head >> 1)) * LSEQ + u) * 64 + (head & 1) * 32;
#pragma unroll
            for (int i = 0; i < 4; ++i) *(uint4*)(o + i * 8) = pack8(t + i * 8);
        }
    }
    {
        u16* vt = (u16*)(ws + WS_VTD);
        const int half = part;
#pragma unroll 4
        for (int c8 = 0; c8 < 16; ++c8) {
            const uint4 rr = *(const uint4*)(pr + C_DV + half * 128 + c8 * 8);
            const unsigned wds[4] = {rr.x, rr.y, rr.z, rr.w};
#pragma unroll
            for (int j = 0; j < 8; ++j) {
                const int dim = half * 128 + c8 * 8 + j, hv = dim >> 6, d = dim & 63;
                const u16 val = (u16)((j & 1) ? (wds[j >> 1] >> 16) : (wds[j >> 1] & 0xffffu));
                vt[((size_t)(b * 4 + hv) * 64 + d) * LSEQ + kpos(u)] = val;
            }
        }
    }
}

constexpr int SSD_XT = 0, SSD_BT = 69632, SSD_DTV = 104448, SSD_EV = 108544, SSD_WV = 112640;
DI void ssd_chunk_item(const Params& P, int layer, int ci, unsigned char* smem) {
    unsigned char* ws = opq_ws(P);
    const int tid = opq_tid(), lane = tid & 63, wave = tid >> 6, r = lane & 31, hh = lane >> 5;
    const int b = ci / NCH, c = ci % NCH, u0 = c * 128, row0 = b * LSEQ + u0;
    const u16* pb = (const u16*)(ws + WS_P);
    u16* XT = (u16*)(smem + SSD_XT); u16* BT = (u16*)(smem + SSD_BT);
    float* dtv = (float*)(smem + SSD_DTV); float* Ev = (float*)(smem + SSD_EV); float* wvp = (float*)(smem + SSD_WV);
    {
        const int dir = wave >> 2, h = wave & 3;
        const float a = -expf(P.in[I_SALOG][layer * 8 + dir * 4 + h]);
        const float bias = P.in[I_SDTB][layer * 8 + dir * 4 + h];
        const int t0 = lane, t1 = lane + 64;
        const float r0 = bf2f(pb[(size_t)(row0 + t0) * PC + C_SDT + dir * 4 + h]) + bias;
        const float r1 = bf2f(pb[(size_t)(row0 + t1) * PC + C_SDT + dir * 4 + h]) + bias;
        const float dt0 = fmaxf(r0, 0.f) + __logf(1.f + __expf(-fabsf(r0))), dt1 = fmaxf(r1, 0.f) + __logf(1.f + __expf(-fabsf(r1)));
        const float dA0 = dt0 * a, dA1 = dt1 * a;
        float s0 = dA0, s1 = dA1;
#pragma unroll
        for (int o = 1; o < 64; o <<= 1) { const float n0 = __shfl_up(s0, o, 64), n1 = __shfl_up(s1, o, 64); if (lane >= o) { s0 += n0; s1 += n1; } }
        const float tot0 = __shfl(s0, 63, 64); s1 += tot0;
        const float total = __shfl(s1, 63, 64);
        const float E0 = dir ? (total - s0 + dA0) : s0, E1 = dir ? (total - s1 + dA1) : s1;
        dtv[wave * 128 + t0] = dt0; dtv[wave * 128 + t1] = dt1;
        Ev[wave * 128 + t0] = E0; Ev[wave * 128 + t1] = E1;
        wvp[wave * 128 + kpos(t0)] = expf(total - E0) * dt0; wvp[wave * 128 + kpos(t1)] = expf(total - E1) * dt1;
        float* gdt = (float*)(ws + WS_SDT); float* ge = (float*)(ws + WS_SE);
        gdt[(size_t)(row0 + t0) * 8 + wave] = dt0; gdt[(size_t)(row0 + t1) * 8 + wave] = dt1;
        ge[(size_t)(row0 + t0) * 8 + wave] = E0; ge[(size_t)(row0 + t1) * 8 + wave] = E1;
        if (lane == 0) ((float*)(ws + WS_SCD))[((b * 2 + dir) * NCH + c) * 4 + h] = expf(total);
    }
    {
        const int cidx = tid;
        const float* cw = P.in[I_SCW] + (size_t)layer * 3 * 512;
        const float w0 = cw[cidx], w1 = cw[512 + cidx], w2 = cw[1024 + cidx], cb = P.in[I_SCB][layer * 512 + cidx];
        const u16* col = pb + (size_t)row0 * PC + C_SXBC + cidx;
        const bool lv = (u0 != 0) && (u0 != CTX), rv = (u0 + 128 != CTX) && (u0 + 128 != LSEQ);
        float prev = lv ? bf2f(col[-(ptrdiff_t)PC]) : 0.f, cur = bf2f(col[0]);
        u16* gx = (u16*)(ws + WS_SXS); u16* gb = (u16*)(ws + WS_SB); u16* gc = (u16*)(ws + WS_SC);
#pragma unroll 16
        for (int t = 0; t < 128; ++t) {
            const float nxt = (t < 127) ? bf2f(col[(size_t)(t + 1) * PC]) : (rv ? bf2f(col[(size_t)128 * PC]) : 0.f);
            const u16 bv = f2bf(silu_f(w0 * prev + w1 * cur + w2 * nxt + cb));
            if (cidx < 256) { gx[(size_t)(row0 + t) * 256 + cidx] = bv; XT[cidx * 136 + kpos(t)] = bv; }
            else if (cidx < 384) { gb[(size_t)(row0 + t) * 128 + cidx - 256] = bv; BT[(cidx - 256) * 136 + kpos(t)] = bv; }
            else gc[(size_t)(row0 + t) * 128 + cidx - 384] = bv;
            prev = cur; cur = nxt;
        }
    }
    __syncthreads();
    {
        const int dir = wave >> 2, h = wave & 3, g = h >> 1;
        f32x16 acc[2][2];
#pragma unroll
        for (int mi = 0; mi < 2; ++mi)
#pragma unroll
            for (int ni = 0; ni < 2; ++ni) acc[mi][ni] = zero16();
#pragma unroll
        for (int s = 0; s < 8; ++s) {
            const float4 wa = *(const float4*)(wvp + wave * 128 + 16 * s + 8 * hh), wb = *(const float4*)(wvp + wave * 128 + 16 * s + 8 * hh + 4);
            const float wts[8] = {wa.x, wa.y, wa.z, wa.w, wb.x, wb.y, wb.z, wb.w};
            bf16x8 aw[2], bb[2];
#pragma unroll
            for (int mi = 0; mi < 2; ++mi) {
                const uint4 rw = *(const uint4*)(XT + (h * 64 + mi * 32 + r) * 136 + 16 * s + 8 * hh);
                float x[8]; unpack8(rw, x);
#pragma unroll
                for (int j = 0; j < 8; ++j) x[j] *= wts[j];
                const uint4 pk = pack8(x); aw[mi] = __builtin_bit_cast(bf16x8, pk);
            }
#pragma unroll
            for (int ni = 0; ni < 2; ++ni) bb[ni] = *(const bf16x8*)(BT + (g * 64 + ni * 32 + r) * 136 + 16 * s + 8 * hh);
#pragma unroll
            for (int mi = 0; mi < 2; ++mi)
#pragma unroll
                for (int ni = 0; ni < 2; ++ni) acc[mi][ni] = MFMA32(aw[mi], bb[ni], acc[mi][ni]);
        }
        float* st = (float*)(ws + WS_SST) + ((size_t)((b * 2 + dir) * NCH + c) * 4 + h) * 4096;
#pragma unroll
        for (int mi = 0; mi < 2; ++mi)
#pragma unroll
            for (int ni = 0; ni < 2; ++ni)
#pragma unroll
                for (int i = 0; i < 16; ++i) st[(mi * 32 + crow(i, hh)) * 64 + ni * 32 + r] = acc[mi][ni][i];
    }
    __syncthreads();
}

constexpr int S5_BU_PITCH = 132;
constexpr int S5_BU_BYTES = 32 * S5_BU_PITCH * 4;
DI void s5_chunk_item(const Params& P, int layer, int ci, unsigned char* smem) {
    unsigned char* ws = opq_ws(P);
    const int tid = opq_tid(), lane = tid & 63, wave = tid >> 6, r = lane & 31, hh = lane >> 5;
    const int b = ci / NCH, c = ci % NCH, row0 = b * LSEQ + c * 128;
    const u16* pb = (const u16*)(ws + WS_P);
    const float* s5a = (const float*)(ws + WS_S5A); const u16* s5bt = (const u16*)(ws + WS_S5BT);
    float* Bu = (float*)(smem + wave * S5_BU_BYTES);
    float* F = (float*)(ws + WS_S5F);
#pragma unroll 1
    for (int gi = 0; gi < 2; ++gi) {
        const int g = wave + 8 * gi;
        bf16x8 afs[4];
#pragma unroll
        for (int q = 0; q < 4; ++q) afs[q] = *(const bf16x8*)(pb + (size_t)(row0 + q * 32 + r) * PC + C_S5U + g * 16 + 8 * hh);
#pragma unroll 1
        for (int dir = 0; dir < 2; ++dir) {
            const size_t ldg = (size_t)(layer * 2 + dir) * 16 + g;
            const float ar = s5a[(ldg * 64 + lane) * 2], ai = s5a[(ldg * 64 + lane) * 2 + 1], nai = -ai;
            bf16x8 bfr[4];
#pragma unroll
            for (int ct = 0; ct < 4; ++ct) bfr[ct] = *(const bf16x8*)(s5bt + (ldg * 128 + ct * 32 + r) * 16 + 8 * hh);
            float sre = 0.f, sim = 0.f;
#pragma unroll
            for (int tbi = 0; tbi < 4; ++tbi) {
                const bf16x8 af = dir ? afs[3 - tbi] : afs[tbi];
#pragma unroll
                for (int ct = 0; ct < 4; ++ct) {
                    const f32x16 acc = MFMA32(af, bfr[ct], zero16());
#pragma unroll
                    for (int i = 0; i < 16; ++i) Bu[crow(i, hh) * S5_BU_PITCH + ct * 32 + r] = acc[i];
                }
                wave_lds_fence();
#pragma unroll 1
                for (int hb = 0; hb < 2; ++hb) {
                    float bre[16], bim[16];
#pragma unroll
                    for (int q = 0; q < 16; ++q) {
                        const int tti = hb * 16 + q, tt = dir ? 31 - tti : tti;
                        bre[q] = Bu[tt * S5_BU_PITCH + lane]; bim[q] = Bu[tt * S5_BU_PITCH + 64 + lane];
                    }
                    wave_lds_fence();
#pragma unroll
                    for (int q = 0; q < 16; ++q) {
                        const float nre = fma_asm(ar, sre, fma_asm(nai, sim, bre[q])), nim = fma_asm(ar, sim, fma_asm(ai, sre, bim[q]));
                        sre = nre; sim = nim;
                    }
                }
                wave_lds_fence();
            }
            float* fo = F + ((((size_t)(b * 2 + dir) * NCH + c) * 16 + g) * 64 + lane) * 2;
            fo[0] = sre; fo[1] = sim;
        }
    }
}

DI void ph_prep(const Params& P, int layer, unsigned char* smem, int typemask = 15) {
    const int tid = opq_tid();
    {
        float* cs = (float*)(smem + LDS_TAB); float* gn = (float*)(smem + LDS_GAIN);
        for (int i = tid; i < 1024; i += NTHR) {
            const int pos = i >> 3, f = i & 7;
            const float inv = expf(-(float)f * (9.210340371976184f / 8.f));
            float sn, cn; sincosf((float)pos * inv, &sn, &cn);
            cs[i * 2] = cn; cs[i * 2 + 1] = sn;
        }
        if (tid < 96) { gn[tid] = P.in[I_MQN][layer * 96 + tid]; gn[96 + tid] = P.in[I_MKN][layer * 96 + tid]; }
        if (tid < 128) gn[192 + tid] = P.in[I_MKVN][layer * 128 + tid];
        if (tid < 32) { gn[320 + tid] = P.in[I_DQN][layer * 32 + tid]; gn[352 + tid] = P.in[I_DKN][layer * 32 + tid]; }
        __syncthreads();
    }
    if (typemask & 1) for (int it = blockIdx.x; it < 132; it += gridDim.x) { s5_chunk_item(P, layer, it, smem); __syncthreads(); }
    if (typemask & 2) for (int it = blockIdx.x; it < 396; it += gridDim.x) if (it >= 132 && it < 264) { ssd_chunk_item(P, layer, it - 132, smem); __syncthreads(); }
    if (typemask & 4) for (int it = blockIdx.x; it < 396; it += gridDim.x) if (it >= 264 && it < 330) { mla_prep_item(P, it - 264, smem); __syncthreads(); }
    if (typemask & 8) for (int it = blockIdx.x; it < 396; it += gridDim.x) if (it >= 330) { diff_prep_item(P, it - 330, smem); __syncthreads(); }
}

constexpr int VP = 144;
constexpr int ATT_STAGE = 64 * 208 + 64 * VP;

template <int DK, int QT>
DI void attn_pass(const u16* __restrict__ Qg, const u16* __restrict__ Kg, int pitch, const u16* __restrict__ Vg, int qrow0, int nkt,
                  float negbound, unsigned char* smem, float (&outv)[QT][2][16]) {
    const int tid = opq_tid(), lane = tid & 63, r = lane & 31, hh = lane >> 5;
    constexpr int KP = DK * 2 + 16;
    constexpr int KCH = DK / 8;
    constexpr int NKC = 64 * KCH;
    constexpr int NQF = DK / 16;
    bf16x8 qf[QT][NQF];
#pragma unroll
    for (int qs = 0; qs < QT; ++qs)
#pragma unroll
        for (int s = 0; s < NQF; ++s) qf[qs][s] = *(const bf16x8*)(Qg + (size_t)(qrow0 + qs * 32 + r) * pitch + 16 * s + 8 * hh);
    const int kc0 = tid, kc1 = tid + 512;
    const int k_row0 = kc0 / KCH, k_col0 = kc0 % KCH, k_row1 = kc1 / KCH, k_col1 = kc1 % KCH;
    const int v_row = tid >> 3, v_col = tid & 7;
    uint4 k0_0 = make_uint4(0, 0, 0, 0), k0_1 = make_uint4(0, 0, 0, 0), v0_;
#define ATT_LOAD(S, kt_) do { const size_t key0 = (size_t)(kt_) * 64; \
        if (kc0 < NKC) k##S##_0 = *(const uint4*)(Kg + (key0 + k_row0) * pitch + k_col0 * 8); \
        if (kc1 < NKC) k##S##_1 = *(const uint4*)(Kg + (key0 + k_row1) * pitch + k_col1 * 8); \
        v##S##_ = *(const uint4*)(Vg + (size_t)v_row * LSEQ + key0 + v_col * 8); } while (0)
#define ATT_STORE(S, sb_) do { unsigned char* sbw = (sb_); \
        if (kc0 < NKC) *(uint4*)(sbw + k_row0 * KP + k_col0 * 16) = k##S##_0; \
        if (kc1 < NKC) *(uint4*)(sbw + k_row1 * KP + k_col1 * 16) = k##S##_1; \
        *(uint4*)(sbw + 64 * KP + v_row * VP + v_col * 16) = v##S##_; } while (0)
    f32x16 o[QT][2];
    float l[QT];
#pragma unroll
    for (int qs = 0; qs < QT; ++qs) { o[qs][0] = zero16(); o[qs][1] = zero16(); l[qs] = 0.f; }
    ATT_LOAD(0, 0);
    ATT_STORE(0, smem);
    __syncthreads();
    for (int kt = 0; kt < nkt; ++kt) {
        const unsigned char* sb = smem + (kt & 1) * ATT_STAGE;
        const unsigned char* vb = sb + 64 * KP;
        ATT_LOAD(0, min(kt + 1, nkt - 1));
#pragma unroll
        for (int k2 = 0; k2 < 2; ++k2) {
            f32x16 sa[QT];
#pragma unroll
            for (int qs = 0; qs < QT; ++qs)
#pragma unroll
                for (int i = 0; i < 16; ++i) sa[qs][i] = negbound;
#pragma unroll
            for (int s = 0; s < NQF; ++s) {
                const bf16x8 kf = ld_frag(sb + (k2 * 32 + r) * KP + s * 32 + hh * 16);
#pragma unroll
                for (int qs = 0; qs < QT; ++qs) sa[qs] = MFMA32(kf, qf[qs][s], sa[qs]);
            }
            bf16x8 pf[QT][2];
#pragma unroll
            for (int qs = 0; qs < QT; ++qs) {
                float pv[16];
#pragma unroll
                for (int i = 0; i < 16; ++i) { pv[i] = __builtin_amdgcn_exp2f(sa[qs][i]); l[qs] += pv[i]; }
                const uint4 p0 = pack8(pv), p1 = pack8(pv + 8);
                pf[qs][0] = __builtin_bit_cast(bf16x8, p0); pf[qs][1] = __builtin_bit_cast(bf16x8, p1);
            }
#pragma unroll
            for (int dt = 0; dt < 2; ++dt) {
                const bf16x8 vf0 = ld_frag(vb + (dt * 32 + r) * VP + (2 * k2) * 32 + hh * 16);
                const bf16x8 vf1 = ld_frag(vb + (dt * 32 + r) * VP + (2 * k2 + 1) * 32 + hh * 16);
#pragma unroll
                for (int qs = 0; qs < QT; ++qs) { o[qs][dt] = MFMA32(vf0, pf[qs][0], o[qs][dt]); o[qs][dt] = MFMA32(vf1, pf[qs][1], o[qs][dt]); }
            }
        }
        ATT_STORE(0, smem + ((kt + 1) & 1) * ATT_STAGE);
        __syncthreads();
    }
#pragma unroll
    for (int qs = 0; qs < QT; ++qs) {
        const float lt = l[qs] + __shfl_xor(l[qs], 32, 64);
        const float il = 1.f / lt;
#pragma unroll
        for (int dt = 0; dt < 2; ++dt)
#pragma unroll
            for (int i = 0; i < 16; ++i) outv[qs][dt][i] = o[qs][dt][i] * il;
    }
}

template <bool MLA>
DI void attn_item(const Params& P, int layer, int b, int head, int qt, float negbound, int which, unsigned char* smem) {
    unsigned char* ws = opq_ws(P);
    const int tid = opq_tid(), lane = tid & 63, wave = tid >> 6, r = lane & 31, hh = lane >> 5;
    constexpr int PITCH = MLA ? 96 : 64;
    constexpr int QT = MLA ? 1 : 2;
    const u16* Qg = (const u16*)(ws + (MLA ? WS_QM : WS_QD)) + (size_t)(b * 4 + head) * LSEQ * PITCH;
    const u16* Kg = (const u16*)(ws + (MLA ? WS_KM : WS_KD)) + (size_t)(b * 4 + head) * LSEQ * PITCH;
    const u16* Vg = (const u16*)(ws + (MLA ? WS_VTM : WS_VTD)) + (size_t)(b * 4 + head) * 64 * LSEQ;
    const bool ctx = qt == 32 / QT;
    const int nkt = ctx ? (CTX / 64) : (LSEQ / 64);
    const int qrow0 = ctx ? ((QT == 2 ? (wave & 3) : wave) * 32 * QT) : CTX + qt * 256 * QT + wave * 32 * QT;
    const bool do_store = !(ctx && QT == 2 && wave >= 4);
    float outv[QT][2][16];
    unsigned char* wreg = smem + 2 * ATT_STAGE + wave * 8192;
    if constexpr (MLA) {
        attn_pass<96, QT>(Qg, Kg, 96, Vg, qrow0, nkt, negbound, smem, outv);
    } else {
        attn_pass<32, QT>(Qg + which * 32, Kg + which * 32, 64, Vg, qrow0, nkt, negbound, smem, outv);
    }
    wave_lds_fence();
    unsigned char* ob = wreg;
#pragma unroll
    for (int qs = 0; qs < QT; ++qs)
#pragma unroll
        for (int dt = 0; dt < 2; ++dt)
#pragma unroll
            for (int q4 = 0; q4 < 4; ++q4) {
                uint2 w;
                w.x = pack_bf2(outv[qs][dt][4 * q4], outv[qs][dt][4 * q4 + 1]); w.y = pack_bf2(outv[qs][dt][4 * q4 + 2], outv[qs][dt][4 * q4 + 3]);
                *(uint2*)(ob + (qs * 32 + r) * 128 + (dt * 32 + 8 * q4 + 4 * hh) * 2) = w;
            }
    wave_lds_fence();
    if (do_store) {
        u16* dst = MLA ? (u16*)(ws + WS_CAT) : (u16*)(ws + WS_Y) + (size_t)which * T * 256;
        const int pitch_o = MLA ? 1024 : 256;
#pragma unroll
        for (int it = 0; it < 4 * QT; ++it) {
            const int idx = it * 64 + lane, qr = idx >> 3, ch = idx & 7;
            const uint4 v = *(const uint4*)(ob + qr * 128 + ch * 16);
            const size_t row = (size_t)b * LSEQ + qrow0 + qr;
            *(uint4*)(dst + row * pitch_o + head * 64 + ch * 8) = v;
        }
    }
    __syncthreads();
}

DI void ph_attn(const Params& P, int layer, unsigned char* smem, bool do_scans, int typemask = 3) {
    unsigned char* ws = opq_ws(P);
    const int tid = opq_tid();
    const int sblk = (gridDim.x == 256) ? (int)blockIdx.x - 128 : (int)blockIdx.x;
    if (do_scans && sblk >= 0 && sblk < 128) {
        const int e = sblk * NTHR + tid;
        const int el = e & 4095, h = (e >> 12) & 3, dir = (e >> 14) & 1, b = e >> 15;
        float* st = (float*)(ws + WS_SST); const float* cd = (const float*)(ws + WS_SCD);
        float hc = 0.f;
#pragma unroll 6
        for (int k = 0; k < NCH; ++k) {
            const int c = chunk_at(dir, k);
            const size_t off = ((size_t)((b * 2 + dir) * NCH + c) * 4 + h) * 4096 + el;
            const float s = st[off];
            st[off] = hc;
            hc = hc * cd[((b * 2 + dir) * NCH + c) * 4 + h] + s;
        }
    }
    if (do_scans && sblk >= 120 && sblk < 128) {
        const int e = (sblk - 120) * NTHR + tid;
        const int p = e & 63, g = (e >> 6) & 15, dir = (e >> 10) & 1, b = e >> 11;
        const float* s5a = (const float*)(ws + WS_S5A);
        const size_t ldg = (size_t)(layer * 2 + dir) * 16 + g;
        float ar = s5a[(ldg * 64 + p) * 2], ai = s5a[(ldg * 64 + p) * 2 + 1];
#pragma unroll
        for (int q = 0; q < 7; ++q) { const float nr = ar * ar - ai * ai, ni = 2.f * ar * ai; ar = nr; ai = ni; }
        float* F = (float*)(ws + WS_S5F);
        float cr = 0.f, cim = 0.f;
#pragma unroll 6
        for (int k = 0; k < NCH; ++k) {
            const int c = chunk_at(dir, k);
            float* fo = F + ((((size_t)(b * 2 + dir) * NCH + c) * 16 + g) * 64 + p) * 2;
            const float fr = fo[0], fi = fo[1];
            fo[0] = cr; fo[1] = cim;
            const float nr = ar * cr - ai * cim + fr, ni = ar * cim + ai * cr + fi;
            cr = nr; cim = ni;
        }
    }
    float nb_m, nb_d;
    {
        const int lane = tid & 63;
        float m = fabsf(P.in[I_MQN][layer * 96 + lane] * P.in[I_MKN][layer * 96 + lane]);
        if (lane < 32) m = fmaxf(m, fabsf(P.in[I_MQN][layer * 96 + 64 + lane] * P.in[I_MKN][layer * 96 + 64 + lane]));
        float m2 = 0.f, s1 = 0.f, s2 = 0.f;
        if (lane < 32) {
            m2 = fabsf(P.in[I_DQN][layer * 32 + lane] * P.in[I_DKN][layer * 32 + lane]);
            s1 = P.in[I_DLQ1][layer * 32 + lane] * P.in[I_DLK1][layer * 32 + lane];
            s2 = P.in[I_DLQ2][layer * 32 + lane] * P.in[I_DLK2][layer * 32 + lane];
        }
#pragma unroll
        for (int o = 32; o >= 1; o >>= 1) {
            m = fmaxf(m, __shfl_xor(m, o, 64)); m2 = fmaxf(m2, __shfl_xor(m2, o, 64));
            s1 += __shfl_xor(s1, o, 64); s2 += __shfl_xor(s2, o, 64);
        }
        nb_m = -(m * 1.413546682e+01f);
        nb_d = -(m2 * 8.161115573e+00f);
        (void)s1; (void)s2;
    }
    __syncthreads();
    for (int k = 0; k < 3; ++k) {
        int first = -1, stride = 1000;
        if (gridDim.x == 256) {
            const int bx = blockIdx.x;
            if (k == 0) first = bx; else if (k == 1) first = 256 + bx; else if (bx < 24) first = 512 + bx;
        } else if (k == 0) { first = blockIdx.x; stride = gridDim.x; }
        for (int j = first; j >= 0 && j < 536; j += stride) {
            const bool mla = (j >= 256 && j < 512) || j >= 528;
            if (mla && (typemask & 1)) { const int q = (j >= 528) ? j - 528 : j - 256; attn_item<true>(P, layer, (q & 7) >> 2, q & 3, (j >= 528) ? 32 : (q >> 3), nb_m, 0, smem); }
        }
        for (int j = first; j >= 0 && j < 536; j += stride) {
            const bool mla = (j >= 256 && j < 512) || j >= 528;
            if (!mla && (typemask & 2)) {
                const bool cx = j >= 512; const int q = cx ? j - 512 : j;
                attn_item<false>(P, layer, (q & 7) >> 2, q & 3, cx ? 16 : ((q & 127) >> 3), nb_d, cx ? (q >> 3) : (q >> 7), smem);
            }
        }
    }
}

constexpr int SO_B = 0, SO_C = 36864, SO_XT = 73728, SO_E = 143360, SO_DT = 147456;
constexpr int SO_YP = 528;
DI void ssd_out_item(const Params& P, int layer, int ci, unsigned char* smem) {
    unsigned char* ws = opq_ws(P);
    const int tid = opq_tid(), lane = tid & 63, wave = tid >> 6, r = lane & 31, hh = lane >> 5;
    const int b = ci / NCH, c = ci % NCH, row0 = b * LSEQ + c * 128;
    unsigned char* Bm = smem + SO_B; unsigned char* Cm = smem + SO_C; u16* XT = (u16*)(smem + SO_XT);
    float* Es = (float*)(smem + SO_E); float* dts = (float*)(smem + SO_DT);
    {
        const u16* gb = (const u16*)(ws + WS_SB); const u16* gc = (const u16*)(ws + WS_SC); const u16* gx = (const u16*)(ws + WS_SXS);
#pragma unroll
        for (int it = 0; it < 4; ++it) {
            const int idx = it * NTHR + tid, t = idx >> 4, cch = idx & 15, g = cch >> 3, n8 = cch & 7;
            *(uint4*)(Bm + g * 18432 + t * 144 + n8 * 16) = *(const uint4*)(gb + (size_t)(row0 + t) * 128 + cch * 8);
            *(uint4*)(Cm + g * 18432 + t * 144 + n8 * 16) = *(const uint4*)(gc + (size_t)(row0 + t) * 128 + cch * 8);
        }
#pragma unroll 2
        for (int it = 0; it < 8; ++it) {
            const int idx = it * NTHR + tid, cc = idx & 255, kq = idx >> 8;
            const int k16 = kq >> 1, hb = kq & 1;
            const u16* src = gx + (size_t)(row0 + 16 * k16 + 4 * hb) * 256 + cc;
            uint4 o;
            o.x = (unsigned)src[0] | ((unsigned)src[256] << 16);
            o.y = (unsigned)src[512] | ((unsigned)src[768] << 16);
            o.z = (unsigned)src[8 * 256] | ((unsigned)src[9 * 256] << 16);
            o.w = (unsigned)src[10 * 256] | ((unsigned)src[11 * 256] << 16);
            *(uint4*)(XT + cc * 136 + 16 * k16 + 8 * hb) = o;
        }
        const float* ge = (const float*)(ws + WS_SE); const float* gdt = (const float*)(ws + WS_SDT);
#pragma unroll
        for (int it = 0; it < 2; ++it) {
            const int idx = it * NTHR + tid, t = idx >> 3, w = idx & 7;
            Es[w * 128 + t] = ge[(size_t)(row0 + t) * 8 + w];
            dts[w * 128 + t] = gdt[(size_t)(row0 + t) * 8 + w];
        }
    }
    __syncthreads();
    const int h = wave & 3, th = wave >> 2, g = h >> 1;
    f32x16 Y[2][2];
#pragma unroll
    for (int a = 0; a < 2; ++a)
#pragma unroll
        for (int q = 0; q < 2; ++q) Y[a][q] = zero16();
    const unsigned char* Bg = Bm + g * 18432; const unsigned char* Cg = Cm + g * 18432;
#pragma unroll 1
    for (int dir = 0; dir < 2; ++dir) {
        const int w = dir * 4 + h;
        bf16x8 hf[2][4];
        {
            const float* hin = (const float*)(ws + WS_SST) + ((size_t)((b * 2 + dir) * NCH + c) * 4 + h) * 4096;
#pragma unroll
            for (int pt = 0; pt < 2; ++pt)
#pragma unroll
                for (int s = 0; s < 4; ++s) {
                    const float4 x0 = *(const float4*)(hin + (pt * 32 + r) * 64 + 16 * s + 8 * hh), x1 = *(const float4*)(hin + (pt * 32 + r) * 64 + 16 * s + 8 * hh + 4);
                    uint4 pk; pk.x = pack_bf2(x0.x, x0.y); pk.y = pack_bf2(x0.z, x0.w); pk.z = pack_bf2(x1.x, x1.y); pk.w = pack_bf2(x1.z, x1.w);
                    hf[pt][s] = __builtin_bit_cast(bf16x8, pk);
                }
        }
#pragma unroll
        for (int tti = 0; tti < 2; ++tti) {
            const int tt = 2 * th + tti, t = tt * 32 + r;
            const float Et = Es[w * 128 + t];
            bf16x8 cq[4];
#pragma unroll
            for (int s = 0; s < 4; ++s) cq[s] = ld_frag(Cg + t * 144 + s * 32 + hh * 16);
            const int jlo = dir ? tt : 0, jhi = dir ? 3 : tt;
#pragma unroll 1
            for (int jt = jlo; jt <= jhi; ++jt) {
                f32x16 ga = zero16();
#pragma unroll
                for (int s = 0; s < 4; ++s) ga = MFMA32(ld_frag(Bg + (jt * 32 + r) * 144 + s * 32 + hh * 16), cq[s], ga);
                float lv[16];
#pragma unroll
                for (int i = 0; i < 16; ++i) {
                    const int j = jt * 32 + crow(i, hh);
                    const bool valid = dir ? (j >= t) : (j <= t);
                    const float arg = valid ? (Et - Es[w * 128 + j]) : 0.f;
                    lv[i] = valid ? ga[i] * __expf(arg) * dts[w * 128 + j] : 0.f;
                }
                const uint4 p0 = pack8(lv), p1 = pack8(lv + 8);
                const bf16x8 lf0 = __builtin_bit_cast(bf16x8, p0), lf1 = __builtin_bit_cast(bf16x8, p1);
#pragma unroll
                for (int pt = 0; pt < 2; ++pt) {
                    const u16* xr = XT + (h * 64 + pt * 32 + r) * 136 + 32 * jt + 8 * hh;
                    Y[pt][tti] = MFMA32(*(const bf16x8*)(xr), lf0, Y[pt][tti]);
                    Y[pt][tti] = MFMA32(*(const bf16x8*)(xr + 16), lf1, Y[pt][tti]);
                }
            }
            const float sc = __expf(Et);
#pragma unroll
            for (int pt = 0; pt < 2; ++pt) {
                f32x16 ho = zero16();
#pragma unroll
                for (int s = 0; s < 4; ++s) ho = MFMA32(hf[pt][s], cq[s], ho);
#pragma unroll
                for (int i = 0; i < 16; ++i) Y[pt][tti][i] += sc * ho[i];
            }
        }
    }
    {
        const float dsk = P.in[I_SD][layer * 4 + h];
#pragma unroll
        for (int tti = 0; tti < 2; ++tti) {
            const int t = (2 * th + tti) * 32 + r;
#pragma unroll
            for (int pt = 0; pt < 2; ++pt)
#pragma unroll
                for (int i = 0; i < 16; ++i) Y[pt][tti][i] += dsk * bf2f(XT[(h * 64 + pt * 32 + crow(i, hh)) * 136 + kpos(t)]);
        }
    }
    __syncthreads();
    {
        unsigned char* Ys = smem + SO_XT;
#pragma unroll
        for (int tti = 0; tti < 2; ++tti) {
            const int t = (2 * th + tti) * 32 + r;
#pragma unroll
            for (int pt = 0; pt < 2; ++pt)
#pragma unroll
                for (int q4 = 0; q4 < 4; ++q4) {
                    uint2 o; o.x = pack_bf2(Y[pt][tti][4 * q4], Y[pt][tti][4 * q4 + 1]); o.y = pack_bf2(Y[pt][tti][4 * q4 + 2], Y[pt][tti][4 * q4 + 3]);
                    *(uint2*)(Ys + t * SO_YP + (h * 64 + pt * 32 + 8 * q4 + 4 * hh) * 2) = o;
                }
        }
    }
    __syncthreads();
    {
        const unsigned char* Ys = smem + SO_XT;
        const u16* pb = (const u16*)(ws + WS_P); u16* cat = (u16*)(ws + WS_CAT);
        const int c8 = tid & 31, tl = tid >> 5;
        float gn[8];
#pragma unroll
        for (int j = 0; j < 8; ++j) gn[j] = P.in[I_SNORM][layer * 256 + c8 * 8 + j];
#pragma unroll 2
        for (int it = 0; it < 8; ++it) {
            const int t = it * 16 + tl;
            const uint4 yr = *(const uint4*)(Ys + t * SO_YP + c8 * 16);
            const uint4 zr = *(const uint4*)(pb + (size_t)(row0 + t) * PC + C_SZ + c8 * 8);
            float y[8], z[8]; unpack8(yr, y); unpack8(zr, z);
            float ss = 0.f;
#pragma unroll
            for (int j = 0; j < 8; ++j) { y[j] *= silu_f(z[j]); ss += y[j] * y[j]; }
#pragma unroll
            for (int o = 16; o >= 1; o >>= 1) ss += __shfl_xor(ss, o, 64);
            const float rstd = rsqrtf(ss * (1.f / 256.f) + EPS);
#pragma unroll
            for (int j = 0; j < 8; ++j) y[j] *= rstd * gn[j];
            *(uint4*)(cat + (size_t)(row0 + t) * 1024 + 256 + c8 * 8) = pack8(y);
        }
    }
    __syncthreads();
}

DI float gelu_tanh(float x) {
    const float z = 0.7978845608028654f * (x + 0.044715f * x * x * x);
    const float th = 1.f - 2.f / (1.f + __expf(2.f * z));
    return 0.5f * x * (1.f + th);
}

typedef __attribute__((ext_vector_type(4))) float f32x4;
#define MFMA16(a, b, c) __builtin_amdgcn_mfma_f32_16x16x32_bf16((a), (b), (c), 0, 0, 0)
DI void s5_out_item(const Params& P, int layer, int ci, unsigned char* smem) {
    unsigned char* ws = opq_ws(P);
    const int tid = opq_tid(), lane = tid & 63, wave = tid >> 6, r = lane & 31, hh = lane >> 5;
    const int r16 = lane & 15, kq = lane >> 4;
    const int b = ci / NCH, c = ci % NCH, row0 = b * LSEQ + c * 128;
    const u16* pb = (const u16*)(ws + WS_P);
    const float* s5a = (const float*)(ws + WS_S5A); const u16* s5bt = (const u16*)(ws + WS_S5BT); const u16* s5ct = (const u16*)(ws + WS_S5CT);
    float* Bu = (float*)(smem + wave * S5_BU_BYTES);
    const float* F = (const float*)(ws + WS_S5F);
    u16* Gg = (u16*)(ws + WS_HID);
#pragma unroll 1
    for (int gi = 0; gi < 2; ++gi) {
        const int g = wave + 8 * gi;
        f32x4 yv[4][2];
#pragma unroll
        for (int q = 0; q < 4; ++q) { yv[q][0] = (f32x4){0.f, 0.f, 0.f, 0.f}; yv[q][1] = (f32x4){0.f, 0.f, 0.f, 0.f}; }
        bf16x8 afs[4];
#pragma unroll
        for (int q = 0; q < 4; ++q) afs[q] = *(const bf16x8*)(pb + (size_t)(row0 + q * 32 + r) * PC + C_S5U + g * 16 + 8 * hh);
        bf16x8 dfrag;
        {
            const unsigned dv = (unsigned)f2bf(P.in[I_5D][layer * 256 + g * 16 + r16]);
            unsigned w[4];
#pragma unroll
            for (int q = 0; q < 4; ++q) {
                const int k0 = 8 * kq + 2 * q;
                w[q] = (k0 == r16) ? dv : ((k0 + 1 == r16) ? (dv << 16) : 0u);
            }
            const uint4 dq = make_uint4(w[0], w[1], w[2], w[3]);
            dfrag = __builtin_bit_cast(bf16x8, dq);
        }
#pragma unroll 1
        for (int dir = 0; dir < 2; ++dir) {
            asm volatile("" ::: "memory");
            const size_t ldg = (size_t)(layer * 2 + dir) * 16 + g;
            const float ar = s5a[(ldg * 64 + lane) * 2], ai = s5a[(ldg * 64 + lane) * 2 + 1], nai = -ai;
            bf16x8 bfr[4], cfr[4];
#pragma unroll
            for (int ct = 0; ct < 4; ++ct) bfr[ct] = *(const bf16x8*)(s5bt + (ldg * 128 + ct * 32 + r) * 16 + 8 * hh);
#pragma unroll
            for (int s4 = 0; s4 < 4; ++s4) cfr[s4] = *(const bf16x8*)(s5ct + (ldg * 16 + r16) * 128 + 32 * s4 + 8 * kq);
            const float* fi = F + ((((size_t)(b * 2 + dir) * NCH + c) * 16 + g) * 64 + lane) * 2;
            float sre = fi[0], sim = fi[1];
#pragma unroll
            for (int tbi = 0; tbi < 4; ++tbi) {
                const int tb = dir ? 3 - tbi : tbi;
                const bf16x8 af = dir ? afs[3 - tbi] : afs[tbi];
#pragma unroll
                for (int ct = 0; ct < 4; ++ct) {
                    const f32x16 acc = MFMA32(af, bfr[ct], zero16());
#pragma unroll
                    for (int i = 0; i < 16; ++i) Bu[crow(i, hh) * S5_BU_PITCH + ct * 32 + r] = acc[i];
                }
                wave_lds_fence();
#pragma unroll 1
                for (int hb = 0; hb < 2; ++hb) {
                    float bre[16], bim[16];
#pragma unroll
                    for (int q = 0; q < 16; ++q) {
                        const int tti = hb * 16 + q, tt = dir ? 31 - tti : tti;
                        bre[q] = Bu[tt * S5_BU_PITCH + lane]; bim[q] = Bu[tt * S5_BU_PITCH + 64 + lane];
                    }
                    wave_lds_fence();
#pragma unroll
                    for (int q = 0; q < 16; ++q) {
                        const int tti = hb * 16 + q, tt = dir ? 31 - tti : tti;
                        const float nre = fma_asm(ar, sre, fma_asm(nai, sim, bre[q])), nim = fma_asm(ar, sim, fma_asm(ai, sre, bim[q]));
                        sre = nre; sim = nim;
                        Bu[tt * S5_BU_PITCH + lane] = __uint_as_float(pack_bf2(sre, sim));
                    }
                }
                wave_lds_fence();
                f32x4 yt[2];
#pragma unroll
                for (int ts = 0; ts < 2; ++ts) {
                    yt[ts] = (f32x4){0.f, 0.f, 0.f, 0.f};
#pragma unroll
                    for (int s4 = 0; s4 < 4; ++s4)
                        yt[ts] = MFMA16(ld_frag((const unsigned char*)Bu + (ts * 16 + r16) * (S5_BU_PITCH * 4) + s4 * 64 + kq * 16), cfr[s4], yt[ts]);
                    if (dir == 0) {
                        uint4 uz = make_uint4(0, 0, 0, 0);
                        if (kq < 2) uz = *(const uint4*)(pb + (size_t)(row0 + tb * 32 + ts * 16 + r16) * PC + C_S5U + g * 16 + 8 * kq);
                        yt[ts] = MFMA16(__builtin_bit_cast(bf16x8, uz), dfrag, yt[ts]);
                    }
                }
                if (dir) { yv[3 - tbi][0] += yt[0]; yv[3 - tbi][1] += yt[1]; } else { yv[tbi][0] += yt[0]; yv[tbi][1] += yt[1]; }
                wave_lds_fence();
            }
        }
        {
            int gofs = (row0 + 4 * kq) * 256 + g * 16 + r16;
            asm volatile("" : "+v"(gofs));
            u16* gp = Gg + gofs;
#pragma unroll
            for (int tb = 0; tb < 4; ++tb)
#pragma unroll
                for (int ts = 0; ts < 2; ++ts)
#pragma unroll
                    for (int i = 0; i < 4; ++i) gp[(tb * 32 + ts * 16 + i) * 256] = f2bf(gelu_tanh(yv[tb][ts][i]));
        }
    }
    __syncthreads();
    unsigned char* G = smem;
#pragma unroll
    for (int it = 0; it < 8; ++it) {
        const int idx = it * NTHR + tid, t = idx >> 5, c8 = idx & 31;
        *(uint4*)(G + t * 528 + c8 * 16) = *(const uint4*)(Gg + (size_t)(row0 + t) * 256 + c8 * 8);
    }
    __syncthreads();
    {
        const int tq = wave & 3, nh = wave >> 2;
        const u16* wg = (const u16*)(ws + WS_WGLU);
        f32x16 acc[4];
#pragma unroll
        for (int ni = 0; ni < 4; ++ni) acc[ni] = zero16();
#pragma unroll 4
        for (int s = 0; s < 16; ++s) {
            const bf16x8 a = ld_frag(G + (tq * 32 + r) * 528 + s * 32 + hh * 16);
#pragma unroll
            for (int ni = 0; ni < 4; ++ni)
                acc[ni] = MFMA32(a, *(const bf16x8*)(wg + (size_t)(nh * 128 + ni * 32 + r) * 256 + 16 * s + 8 * hh), acc[ni]);
        }
        u16* cat = (u16*)(ws + WS_CAT);
#pragma unroll
        for (int ni = 0; ni < 4; ++ni) {
            const int n = nh * 128 + ni * 32 + r;
            const float bg = P.in[I_5BGLU][layer * 256 + n];
#pragma unroll
            for (int i = 0; i < 16; ++i) {
                const int t = tq * 32 + crow(i, hh);
                const float gv = bf2f(*(const u16*)(G + t * 528 + n * 2));
                const float o = gv / (1.f + __expf(-(acc[ni][i] + bg)));
                cat[(size_t)(row0 + t) * 1024 + 512 + n] = f2bf(o);
            }
        }
    }
    __syncthreads();
}

DI void diff_combine(const Params& P, int layer) {
    unsigned char* ws = opq_ws(P);
    const int tid = opq_tid(), lane = tid & 63;
    float s1 = 0.f, s2 = 0.f;
    if (lane < 32) {
        s1 = P.in[I_DLQ1][layer * 32 + lane] * P.in[I_DLK1][layer * 32 + lane];
        s2 = P.in[I_DLQ2][layer * 32 + lane] * P.in[I_DLK2][layer * 32 + lane];
    }
#pragma unroll
    for (int o = 32; o >= 1; o >>= 1) { s1 += __shfl_xor(s1, o, 64); s2 += __shfl_xor(s2, o, 64); }
    const float lam_init = 0.8f - 0.6f * expf(-0.3f * (float)layer);
    const float lam = expf(s1) - expf(s2) + lam_init;
    const u16* o1 = (const u16*)(ws + WS_Y); const u16* o2 = o1 + (size_t)T * 256;
    u16* cat = (u16*)(ws + WS_CAT);
    const int c8 = tid & 7;
    float sg[8];
#pragma unroll
    for (int j = 0; j < 8; ++j) sg[j] = P.in[I_DSUB][layer * 64 + c8 * 8 + j] * (1.f - lam_init);
    for (int rh = blockIdx.x * 64 + (tid >> 3); rh < T * 4; rh += gridDim.x * 64) {
        const size_t off = (size_t)rh * 64 + c8 * 8;
        float a[8], b[8]; unpack8(*(const uint4*)(o1 + off), a); unpack8(*(const uint4*)(o2 + off), b);
        float ss = 0.f;
#pragma unroll
        for (int j = 0; j < 8; ++j) { a[j] -= lam * b[j]; ss += a[j] * a[j]; }
        ss += __shfl_xor(ss, 1, 64); ss += __shfl_xor(ss, 2, 64); ss += __shfl_xor(ss, 4, 64);
        const float rstd = rsqrtf(ss * (1.f / 64.f) + EPS);
#pragma unroll
        for (int j = 0; j < 8; ++j) a[j] *= rstd * sg[j];
        *(uint4*)(cat + (size_t)(rh >> 2) * 1024 + 768 + (rh & 3) * 64 + c8 * 8) = pack8(a);
    }
}

DI void ph_ssm_out(const Params& P, int layer, unsigned char* smem, int typemask = 7) {
    if (typemask & 4) diff_combine(P, layer);
    if (typemask & 1) for (int it = blockIdx.x; it < 132; it += gridDim.x) s5_out_item(P, layer, it, smem);
    if (typemask & 2) for (int it = blockIdx.x; it < 264; it += gridDim.x) if (it >= 132) ssd_out_item(P, layer, it - 132, smem);
}

DI void ph_gemm_out(const Params& P, int layer, unsigned char* smem, float gsign = 1.f) {
    unsigned char* ws = opq_ws(P);
    const u16* cat = (const u16*)(ws + WS_CAT); const u16* wt = (const u16*)(ws + WS_WOUT); float* xb = (float*)(ws + WS_X);
    const float* mods = (const float*)(ws + WS_MODS);
    const int lane = opq_tid() & 63;
    float4 xpre[8];
    gemm_stream<2, 4, 2, 1>(smem, 1024,
        [&](int k, TileDesc& d) {
            const int tile = (int)blockIdx.x + k * (int)gridDim.x;
            if (tile >= (T / 128) * 8) return false;
            const int mt = tile >> 3, nt = tile & 7;
            d.a = cat + (size_t)mt * 128 * 1024; d.lda = 1024; d.gl = nullptr; d.ashift = 0; d.nrow = 128;
            d.b = wt + (size_t)nt * 128 * 1024; d.ldb = 1024; d.u0 = mt * 128; d.u1 = nt * 128; d.u2 = 0; d.u3 = 0;
            return true;
        },
        [&](const TileDesc& d, int step, unsigned char*) {
            if (step == 0) {
                const int w_ = opq_tid() >> 6, wr_ = w_ >> 2, wc_ = w_ & 3;
#pragma unroll
                for (int it = 0; it < 8; ++it) {
                    const int idx = it * 64 + lane, row = idx >> 3, ch = idx & 7;
                    xpre[it] = *(const float4*)(xb + (size_t)(d.u0 + wr_ * 64 + row) * 1024 + d.u1 + wc_ * 32 + ch * 4);
                }
            }
        },
        [&](const TileDesc& d, f32x16 (&acc)[2][1], int r0, int c0, unsigned char* ob, unsigned char*) {
            const int m0 = d.u0, n0 = d.u1;
            const int b = m0 / LSEQ, u = m0 % LSEQ, which = (u < CTX) ? 2 : b;
            const float gt = mods[((size_t)layer * 3 + which) * 6144 + 2 * 1024 + n0 + c0 + (lane & 31)] * gsign;
#pragma unroll
            for (int mi = 0; mi < 2; ++mi)
#pragma unroll
                for (int i = 0; i < 16; ++i) *(float*)(ob + (mi * 32 + crow(i, lane >> 5)) * 144 + (lane & 31) * 4) = gt * acc[mi][0][i];
            asm volatile("s_waitcnt lgkmcnt(0)" ::: "memory"); __builtin_amdgcn_wave_barrier();
#pragma unroll
            for (int it = 0; it < 8; ++it) {
                const int idx = it * 64 + lane, row = idx >> 3, ch = idx & 7;
                const float4 dd = *(const float4*)(ob + row * 144 + ch * 16);
                float4* xp = (float4*)(xb + (size_t)(m0 + r0 + row) * 1024 + n0 + c0 + ch * 4);
                float4 xv = xpre[it]; xv.x += dd.x; xv.y += dd.y; xv.z += dd.z; xv.w += dd.w; *xp = xv;
            }
            asm volatile("s_waitcnt lgkmcnt(0)" ::: "memory"); __builtin_amdgcn_wave_barrier();
        });
}

DI void ph_norm2_route(const Params& P, int layer, unsigned char* smem, bool do_append = true) {
    unsigned char* ws = opq_ws(P);
    const int tid = opq_tid(), lane = tid & 63, wave = tid >> 6;
    float* wr = (float*)smem;
    {
        const float* wg = P.in[I_MWG] + (size_t)layer * 1024 * 4; const float* we = P.in[I_MWE] + (size_t)layer * 4 * 1024 * 8;
        for (int i = tid; i < 4096; i += NTHR) { const int k = i >> 2, o = i & 3; wr[o * 1024 + k] = wg[i]; }
        for (int i = tid; i < 32768; i += NTHR) { const int e = i & 7, k = (i >> 3) & 1023, g = i >> 13; wr[(4 + g * 8 + e) * 1024 + k] = we[i]; }
        if (tid < 4) wr[36 * 1024 + tid] = P.in[I_MBG][layer * 4 + tid];
        if (tid >= 4 && tid < 36) wr[36 * 1024 + tid] = P.in[I_MBE][layer * 32 + tid - 4];
    }
    const float* rb = wr + 36 * 1024;
    __syncthreads();
    const float* xbuf = (const float*)(ws + WS_X); u16* hn = (u16*)(ws + WS_HN);
    const float* mods = (const float*)(ws + WS_MODS);
    const float* g2n = P.in[I_NORM2] + layer * 1024;
    int* tok_e = (int*)(ws + WS_TOKE); float* tok_w = (float*)(ws + WS_TOKW); int* list = (int*)(ws + WS_LIST);
    int* cnt = (int*)(ws + WS_CTL + CTL_CNT_OFF) + layer * 32;
    float4 gv[4];
#pragma unroll
    for (int i = 0; i < 4; ++i) gv[i] = *(const float4*)(g2n + i * 256 + lane * 4);
    for (int row = blockIdx.x * NWAVE + wave; row < T; row += gridDim.x * NWAVE) {
        const int b = row / LSEQ, u = row % LSEQ, which = (u < CTX) ? 2 : b;
        const float* xr = xbuf + (size_t)row * 1024;
        float4 v[4]; float ss = 0.f;
#pragma unroll
        for (int i = 0; i < 4; ++i) { v[i] = *(const float4*)(xr + i * 256 + lane * 4); ss += v[i].x * v[i].x + v[i].y * v[i].y + v[i].z * v[i].z + v[i].w * v[i].w; }
        ss = wave_sum(ss);
        const float rstd = rsqrtf(ss * (1.f / 1024.f) + EPS);
        const float* sh = mods + ((size_t)layer * 3 + which) * 6144 + 3 * 1024; const float* sc = sh + 1024;
#pragma unroll
        for (int i = 0; i < 4; ++i) {
            const float4 s4 = *(const float4*)(sh + i * 256 + lane * 4), c4 = *(const float4*)(sc + i * 256 + lane * 4);
            v[i].x = v[i].x * rstd * gv[i].x * (1.f + c4.x) + s4.x; v[i].y = v[i].y * rstd * gv[i].y * (1.f + c4.y) + s4.y;
            v[i].z = v[i].z * rstd * gv[i].z * (1.f + c4.z) + s4.z; v[i].w = v[i].w * rstd * gv[i].w * (1.f + c4.w) + s4.w;
            uint2 o; o.x = pack_bf2(v[i].x, v[i].y); o.y = pack_bf2(v[i].z, v[i].w);
            *(uint2*)(hn + (size_t)row * 1024 + i * 256 + lane * 4) = o;
        }
        auto dotw = [&](int o) {
            float a = 0.f;
#pragma unroll
            for (int i = 0; i < 4; ++i) { const float4 w4 = *(const float4*)(wr + o * 1024 + i * 256 + lane * 4); a += v[i].x * w4.x + v[i].y * w4.y + v[i].z * w4.z + v[i].w * w4.w; }
            return wave_sum(a);
        };
        float lg[4];
#pragma unroll
        for (int o = 0; o < 4; ++o) lg[o] = dotw(o) + rb[o];
        int gi = 0; float gm = lg[0];
#pragma unroll
        for (int o = 1; o < 4; ++o) if (lg[o] > gm) { gm = lg[o]; gi = o; }
        float den = 0.f;
#pragma unroll
        for (int o = 0; o < 4; ++o) den += __expf(lg[o] - gm);
        const float pg = 1.f / den;
        float le[8];
#pragma unroll
        for (int e = 0; e < 8; ++e) le[e] = dotw(4 + gi * 8 + e) + rb[4 + gi * 8 + e];
        int e0 = 0; float v0 = le[0];
#pragma unroll
        for (int e = 1; e < 8; ++e) if (le[e] > v0) { v0 = le[e]; e0 = e; }
        int e1 = -1; float v1 = -3.0e38f;
#pragma unroll
        for (int e = 0; e < 8; ++e) if (e != e0 && le[e] > v1) { v1 = le[e]; e1 = e; }
        const float x1 = __expf(v1 - v0);
        const float w0 = pg / (1.f + x1), w1 = pg * x1 / (1.f + x1);
        if (lane == 0) {
            const int ge0 = gi * 8 + e0, ge1 = gi * 8 + e1;
            tok_e[row * 2] = ge0; tok_e[row * 2 + 1] = ge1; tok_w[row * 2] = w0; tok_w[row * 2 + 1] = w1;
            if (do_append) {
                const int p0 = atomicAdd(&cnt[ge0], 1); list[(size_t)ge0 * T + p0] = row * 2;
                const int p1 = atomicAdd(&cnt[ge1], 1); list[(size_t)ge1 * T + p1] = row * 2 + 1;
            }
        }
    }
}

DI int moe_find_tile(const int* cnt, int ti, int ctiles, int& e_out, int& rt_out, int& ct_out, int& ne_out) {
    int base = 0;
    for (int e = 0; e < 32; ++e) {
        const int n = cnt[e]; const int nt = ((n + 127) >> 7) * ctiles;
        if (ti < base + nt) { const int q = ti - base; e_out = e; rt_out = q / ctiles; ct_out = q % ctiles; ne_out = n; return 1; }
        base += nt;
    }
    return 0;
}
DI void ph_moe1(const Params& P, int layer, unsigned char* smem) {
    unsigned char* ws = opq_ws(P);
    const int* cnt = (const int*)(ws + WS_CTL + CTL_CNT_OFF) + layer * 32;
    const int* list = (const int*)(ws + WS_LIST);
    const u16* hn = (const u16*)(ws + WS_HN); const u16* wgu = (const u16*)(ws + WS_WGU); u16* hid = (u16*)(ws + WS_HID);
    const int lane = opq_tid() & 63;
#ifdef DBG_SORTED_LISTS
    {
        const int* tok_e = (const int*)(ws + WS_TOKE); int* wl = (int*)(ws + WS_LIST);
        const int wave = opq_tid() >> 6;
        for (int e = wave; e < 32; e += NWAVE) {
            int base = 0;
            for (int i0 = 0; i0 < 2 * T; i0 += 64) {
                const int en = i0 + lane; const bool m = tok_e[en] == e;
                const unsigned long long bal = __ballot(m);
                if (m) wl[(size_t)e * T + base + __popcll(bal & ((1ull << lane) - 1ull))] = en;
                base += __popcll(bal);
            }
        }
        __syncthreads();
    }
#endif
    int pe = 0;
    gemm_stream<4, 2, 1, 2>(smem, 1024,
        [&](int k, TileDesc& d) {
            int e, rt, ct, ne;
            if (!moe_find_tile(cnt, (int)blockIdx.x + k * (int)gridDim.x, 4, e, rt, ct, ne)) return false;
            d.a = hn; d.lda = 1024; d.gl = list + (size_t)e * T + rt * 128; d.ashift = 1; d.nrow = min(128, ne - rt * 128);
            d.b = wgu + (size_t)e * 512 * 1024 + (size_t)ct * 128 * 1024; d.ldb = 1024; d.u0 = ct; d.u1 = 0; d.u2 = 0; d.u3 = 0;
            return true;
        },
        [&](const TileDesc& d, int step, unsigned char* tab) {
            const int t_ = opq_tid();
            if (step == 0) { if (t_ < 128) pe = d.gl[min(t_, d.nrow - 1)]; }
            else if (t_ < 128) ((int*)tab)[t_] = pe;
        },
        [&](const TileDesc& d, f32x16 (&acc)[1][2], int r0, int c0, unsigned char* ob, unsigned char* tab) {
            const int j0 = d.u0 * 64 + (c0 >> 6) * 32;
            const int* le = (const int*)tab; const int nrow = d.nrow;
            epi_bf16_rows<1, 1>(ob, lane, [&](int, int, int i) { return silu_f(acc[0][0][i]) * acc[0][1][i]; },
                [&](int row, int col, const uint4& v) { const int rr = r0 + row; if (rr < nrow) *(uint4*)(hid + (size_t)le[rr] * 256 + j0 + col) = v; });
        });
}
DI void ph_moe2(const Params& P, int layer, unsigned char* smem) {
    unsigned char* ws = opq_ws(P);
    const int* cnt = (const int*)(ws + WS_CTL + CTL_CNT_OFF) + layer * 32;
    const int* list = (const int*)(ws + WS_LIST); const float* tok_w = (const float*)(ws + WS_TOKW);
    const u16* hid = (const u16*)(ws + WS_HID); const u16* wd = (const u16*)(ws + WS_WD); u16* yb = (u16*)(ws + WS_Y);
    const int lane = opq_tid() & 63;
    int pe = 0; float pw = 0.f;
    gemm_stream<2, 4, 2, 1>(smem, 256,
        [&](int k, TileDesc& d) {
            int e, rt, ct, ne;
            if (!moe_find_tile(cnt, (int)blockIdx.x + k * (int)gridDim.x, 8, e, rt, ct, ne)) return false;
            d.a = hid; d.lda = 256; d.gl = list + (size_t)e * T + rt * 128; d.ashift = 0; d.nrow = min(128, ne - rt * 128);
            d.b = wd + (size_t)e * 1024 * 256 + (size_t)ct * 128 * 256; d.ldb = 256; d.u0 = ct; d.u1 = 0; d.u2 = 0; d.u3 = 0;
            return true;
        },
        [&](const TileDesc& d, int step, unsigned char* tab) {
            const int t_ = opq_tid();
            if (step == 0) { if (t_ < 128) { pe = d.gl[min(t_, d.nrow - 1)]; pw = tok_w[pe]; } }
            else if (t_ < 128) { ((int*)tab)[t_] = pe; ((float*)tab)[128 + t_] = pw; }
        },
        [&](const TileDesc& d, f32x16 (&acc)[2][1], int r0, int c0, unsigned char* ob, unsigned char* tab) {
            const int* le = (const int*)tab; const float* twl = (const float*)tab + 128; const int nrow = d.nrow; const int ct = d.u0;
            float tw[2][16];
#pragma unroll
            for (int mi = 0; mi < 2; ++mi)
#pragma unroll
                for (int i = 0; i < 16; ++i) tw[mi][i] = twl[r0 + mi * 32 + crow(i, lane >> 5)];
            epi_bf16_rows<2, 1>(ob, lane, [&](int mi, int, int i) { return acc[mi][0][i] * tw[mi][i]; },
                [&](int row, int col, const uint4& v) { const int rr = r0 + row; if (rr < nrow) *(uint4*)(yb + (size_t)le[rr] * 1024 + ct * 128 + c0 + col) = v; });
        });
}

DI void ph_final(const Params& P) {
    unsigned char* ws = opq_ws(P);
#ifdef DBG_DUMPF_OFF
    {
        const float* src = (const float*)(ws + DBG_DUMPF_OFF);
#ifndef DBG_DUMPF_N
#define DBG_DUMPF_N ((size_t)NB * SEQ * D)
#endif
        for (size_t i = (size_t)blockIdx.x * NTHR + threadIdx.x; i < (size_t)NB * SEQ * D; i += (size_t)gridDim.x * NTHR) { float vv = (i < (size_t)(DBG_DUMPF_N)) ? src[i] : 0.f;
#ifdef DBG_AMP
            vv = vv * 1048576.f; vv = vv - floorf(vv);
#endif
            P.out[i] = vv; }
        return;
    }
#endif
#ifdef DBG_DUMP_OFF
    {
        const u16* src = (const u16*)(ws + DBG_DUMP_OFF);
#ifndef DBG_DUMP_N
#define DBG_DUMP_N ((size_t)NB * SEQ * D)
#endif
        for (size_t i = (size_t)blockIdx.x * NTHR + threadIdx.x; i < (size_t)NB * SEQ * D; i += (size_t)gridDim.x * NTHR) { float vv = (i < (size_t)(DBG_DUMP_N)) ? bf2f(src[i]) : 0.f;
#ifdef DBG_AMP
            vv = vv * 4096.f; vv = vv - floorf(vv);
#endif
            P.out[i] = vv; }
        return;
    }
#endif
    const int tid = opq_tid(), lane = tid & 63, wave = tid >> 6;
    const float* xbuf = (const float*)(ws + WS_X); const u16* yb = (const u16*)(ws + WS_Y); const float* mods = (const float*)(ws + WS_MODS);
    for (int lr = blockIdx.x * NWAVE + wave; lr < NB * SEQ; lr += gridDim.x * NWAVE) {
        const int b = lr / SEQ, l = lr % SEQ, row = b * LSEQ + CTX + l;
        const float* xr = xbuf + (size_t)row * 1024;
        const float* g2 = mods + ((size_t)(DEPTH - 1) * 3 + b) * 6144 + 5 * 1024;
        const u16* y0 = yb + (size_t)(2 * row) * 1024; const u16* y1 = y0 + 1024;
#pragma unroll
        for (int i = 0; i < 4; ++i) {
            float4 v = *(const float4*)(xr + i * 256 + lane * 4);
            const uint2 a = *(const uint2*)(y0 + i * 256 + lane * 4), c = *(const uint2*)(y1 + i * 256 + lane * 4);
            const float4 gg = *(const float4*)(g2 + i * 256 + lane * 4);
#ifndef DBG_STOP_L
            v.x += gg.x * (bflo(a.x) + bflo(c.x)); v.y += gg.y * (bfhi(a.x) + bfhi(c.x));
            v.z += gg.z * (bflo(a.y) + bflo(c.y)); v.w += gg.w * (bfhi(a.y) + bfhi(c.y));
#endif
            *(float4*)(P.out + (size_t)lr * 1024 + i * 256 + lane * 4) = v;
        }
    }
}

#ifndef DUP_PH
#define DUP_PH 0
#endif
extern __shared__ __attribute__((aligned(16))) unsigned char g_smem[];
__global__ void __launch_bounds__(NTHR, 2) trunk_fwd(Params P) {
    unsigned char* smem = g_smem;
    volatile LAS unsigned* xbw = (volatile LAS unsigned*)(g_smem + LDS_BYTES);
    XcdBarrier bar; bar.bar = (unsigned*)(P.ws + WS_CTL); bar.x = 0; bar.st = xbw;
    if (P.use_bar) {
        if (threadIdx.x == 0) { xbw[0] = 0u; xbw[1] = 0u; xbw[2] = 0u; xbw[3] = 0u; }
        __syncthreads();
        bar = xcd_barrier_post((unsigned*)(P.ws + WS_CTL), xbw);
    }
#define GRID_BAR() do { if (P.use_bar) xcd_barrier(bar); } while (0)
#ifdef ONLY_PH
#define IN(k) ((k) == ONLY_PH && P.ph_lo <= (k) && (k) < P.ph_hi)
#else
#define IN(k) (P.ph_lo <= (k) && (k) < P.ph_hi)
#endif
    if (P.lay_lo == 0 && IN(0)) { ph_prologue(P, smem); GRID_BAR(); if (DUP_PH == 100) { ph_prologue(P, smem); GRID_BAR(); } }
    for (int layer = P.lay_lo; layer < P.lay_hi; ++layer) {
        if (IN(1)) { ph_norm1(P, layer, smem); GRID_BAR(); if (DUP_PH == 1) { ph_norm1(P, layer, smem, false); GRID_BAR(); } }
        if (IN(2)) { ph_gemm_in(P, smem); GRID_BAR(); if (DUP_PH == 2) { ph_gemm_in(P, smem); GRID_BAR(); } }
        if (IN(3)) { const int nr3 = (P.rep_ph == 3) ? 1 : 0; for (int rep = 0; rep <= nr3; ++rep) { ph_prep(P, layer, smem, rep == 0 ? 15 : P.pad0); GRID_BAR(); } }
        if (IN(4)) { const int nr4 = (P.rep_ph == 4) ? 1 : 0; for (int rep = 0; rep <= nr4; ++rep) { ph_attn(P, layer, smem, rep == 0, rep == 0 ? 3 : P.pad0); GRID_BAR(); } }
        if (IN(5)) { const int nr5 = (P.rep_ph == 5) ? 1 : 0; for (int rep = 0; rep <= nr5; ++rep) { ph_ssm_out(P, layer, smem, rep == 0 ? 7 : P.pad0); GRID_BAR(); } }
        if (IN(6)) { ph_gemm_out(P, layer, smem); GRID_BAR(); if (DUP_PH == 6) { ph_gemm_out(P, layer, smem, -1.f); GRID_BAR(); ph_gemm_out(P, layer, smem, 1.f); GRID_BAR(); } }
        if (IN(7)) { ph_norm2_route(P, layer, smem); GRID_BAR(); if (DUP_PH == 7) { ph_norm2_route(P, layer, smem, false); GRID_BAR(); } }
        if (IN(8)) { ph_moe1(P, layer, smem); GRID_BAR(); if (DUP_PH == 8) { ph_moe1(P, layer, smem); GRID_BAR(); } }
        if (DUP_PH == 200) { GRID_BAR(); GRID_BAR(); GRID_BAR(); GRID_BAR(); }
        if (IN(9)) { ph_moe2(P, layer, smem); GRID_BAR(); if (DUP_PH == 9) { ph_moe2(P, layer, smem); GRID_BAR(); } }
    }
    if (P.lay_hi == DEPTH && IN(10)) { ph_final(P); if (DUP_PH == 110) { GRID_BAR(); ph_final(P); } }
#undef IN
#undef GRID_BAR
}

#ifndef N_LAUNCH_MODE
#define N_LAUNCH_MODE 0
#endif
extern "C" void kernel_launch(void* const* d_in, const int* in_sizes, int n_in, void* d_out, int out_size, void* d_ws, size_t ws_size, hipStream_t stream) {
    static int grid = 0;
    constexpr int DYN_LDS = LDS_BYTES + 16;
    if (grid == 0) {
        if (n_in != 45 || out_size != NB * SEQ * D || ws_size < WS_END) {
            fprintf(stderr, "kernel_launch: unexpected shapes (n_in %d out %d ws %zu need %zu)\n", n_in, out_size, ws_size, (size_t)WS_END); grid = -1; return;
        }
        int dev = 0, cus = 0, per_cu = 0;
        hipGetDevice(&dev); hipDeviceGetAttribute(&cus, hipDeviceAttributeMultiprocessorCount, dev);
        hipFuncSetAttribute((const void*)trunk_fwd, hipFuncAttributeMaxDynamicSharedMemorySize, DYN_LDS);
        hipOccupancyMaxActiveBlocksPerMultiprocessor(&per_cu, (const void*)trunk_fwd, NTHR, DYN_LDS);
        (void)hipGetLastError();
        if (per_cu < 1) fprintf(stderr, "kernel_launch: occupancy query says %d blocks/CU\n", per_cu);
        grid = cus;
    }
    if (grid < 0) return;
    hipMemsetAsync((char*)d_ws + WS_CTL, 0, CTL_BYTES, stream);
    Params p; memset(&p, 0, sizeof(p));
    for (int i = 0; i < 45; ++i) p.in[i] = (const float*)d_in[i];
    p.out = (float*)d_out; p.ws = (unsigned char*)d_ws;
#if N_LAUNCH_MODE == 1
    p.lay_lo = 0; p.lay_hi = DEPTH; p.ph_lo = 0; p.ph_hi = 11; p.use_bar = 1;
#ifdef REP_PH
    p.rep_ph = REP_PH; p.pad0 = REP_MASK;
#endif
    hipLaunchKernelGGL(trunk_fwd, dim3(grid), dim3(NTHR), DYN_LDS, stream, p);
#else
    p.use_bar = 0;
    p.lay_lo = 0; p.lay_hi = 0; p.ph_lo = 0; p.ph_hi = 1;
    hipLaunchKernelGGL(trunk_fwd, dim3(grid), dim3(NTHR), DYN_LDS, stream, p);
    for (int l = 0; l < DEPTH; ++l)
        for (int ph = 1; ph <= 9; ++ph) {
#ifdef DBG_STOP_L
            if (l > DBG_STOP_L || (l == DBG_STOP_L && ph > DBG_STOP_P)) continue;
#endif
            p.lay_lo = l; p.lay_hi = l + 1; p.ph_lo = ph; p.ph_hi = ph + 1;
            hipLaunchKernelGGL(trunk_fwd, dim3(grid), dim3(NTHR), DYN_LDS, stream, p);
        }
    p.lay_lo = DEPTH; p.lay_hi = DEPTH; p.ph_lo = 10; p.ph_hi = 11;
    hipLaunchKernelGGL(trunk_fwd, dim3(grid), dim3(NTHR), DYN_LDS, stream, p);
#endif
}
```
